# Optimizing an MI355X kernel written in HIP

```python
import jax, jax.numpy as jnp
from jax import lax
import numpy as np

D_MODEL = 1024
BATCH = 16
SEQ = 4096
DEPTH = 1

RET_HEADS = 8
RET_HEAD_DIM = 64
RET_WIDTH = RET_HEADS * RET_HEAD_DIM
RET_CHUNK = 128
MLA_HEADS = 8
MLA_Q_RANK = 256
MLA_KV_RANK = 128
MLA_NOPE_DIM = 64
MLA_ROPE_DIM = 32
MLA_QK_DIM = MLA_NOPE_DIM + MLA_ROPE_DIM
MLA_V_DIM = 64
MLA_WIDTH = MLA_HEADS * MLA_V_DIM
Q_BLOCK = 128
MIX_WIDTH = RET_WIDTH + MLA_WIDTH
IN_WIDTH = 4 * RET_WIDTH + MLA_Q_RANK + MLA_KV_RANK + MLA_ROPE_DIM
D_FF = -(-8 * D_MODEL // (3 * 256)) * 256
ROPE_BASE = 10000.0
EPS = 1e-6
GN_EPS = 1e-5

kernel_name = 'hybrid_retention_mla_encoder_block'


def rms_norm(x, g, eps=EPS):
    xf = x.astype(jnp.float32)
    y = xf * lax.rsqrt(jnp.mean(xf * xf, axis=-1, keepdims=True) + eps)
    return (y * g.astype(jnp.float32)).astype(x.dtype)


def rotary(x, positions):
    half = x.shape[-1] // 2
    inv_freq = ROPE_BASE ** (-jnp.arange(half, dtype=jnp.float32) / half)
    ang = positions.astype(jnp.float32)[..., None] * inv_freq
    cos = jnp.cos(ang)[:, :, None, :]
    sin = jnp.sin(ang)[:, :, None, :]
    xf = x.astype(jnp.float32)
    x1, x2 = xf[..., :half], xf[..., half:]
    out = jnp.concatenate([x1 * cos - x2 * sin, x2 * cos + x1 * sin], axis=-1)
    return out.astype(x.dtype)


def retention_one_direction(q, k, v, log_gamma, strict):
    C = q.shape[3]
    idx = jnp.arange(C, dtype=jnp.float32)
    diff = idx[:, None] - idx[None, :]
    mask = (diff > 0) if strict else (diff >= 0)
    lg = log_gamma[:, None, None]
    decay = jnp.where(mask, jnp.exp(lg * jnp.where(mask, diff, 0.0)), 0.0)
    scores = jnp.einsum('bhncd,bhnmd->bhncm', q, k) * decay[None, :, None]
    inner = jnp.einsum('bhncm,bhnmd->bhncd', scores, v)
    zeta = jnp.exp(log_gamma[:, None] * (C - 1 - idx)[None, :])
    xi = jnp.exp(log_gamma[:, None] * (idx + 1)[None, :])
    chunk_kv = jnp.einsum('bhncd,bhnce->nbhde', k * zeta[None, :, None, :, None], v)
    chunk_decay = jnp.exp(log_gamma * C)[None, :, None, None]

    def step(state, kv):
        return state * chunk_decay + kv, state

    _, prev = lax.scan(step, jnp.zeros_like(chunk_kv[0]), chunk_kv)
    cross = jnp.einsum('bhncd,nbhde->bhnce', q, prev) * xi[None, :, None, :, None]
    return inner + cross


def retention_mixer(q, k, v, g, positions, logit_fwd, logit_bwd):
    B, S, _ = q.shape
    n_chunks = S // RET_CHUNK

    def heads(t):
        return t.reshape(B, S, RET_HEADS, RET_HEAD_DIM)

    qh = rotary(heads(q), positions).astype(jnp.float32)
    kh = rotary(heads(k), positions).astype(jnp.float32) * (RET_HEAD_DIM ** -0.5)
    vh = heads(v).astype(jnp.float32)

    def chunked(t):
        return t.transpose(0, 2, 1, 3).reshape(B, RET_HEADS, n_chunks, RET_CHUNK, RET_HEAD_DIM)

    lg_f = jax.nn.log_sigmoid(logit_fwd.astype(jnp.float32))
    lg_b = jax.nn.log_sigmoid(logit_bwd.astype(jnp.float32))
    o_f = retention_one_direction(chunked(qh), chunked(kh), chunked(vh), lg_f, strict=False)
    o_b = retention_one_direction(chunked(jnp.flip(qh, 1)), chunked(jnp.flip(kh, 1)),
                                  chunked(jnp.flip(vh, 1)), lg_b, strict=True)
    o = (o_f.reshape(B, RET_HEADS, S, RET_HEAD_DIM)
         + jnp.flip(o_b.reshape(B, RET_HEADS, S, RET_HEAD_DIM), axis=2))
    mu = jnp.mean(o, axis=-1, keepdims=True)
    var = jnp.mean(jnp.square(o - mu), axis=-1, keepdims=True)
    o = (o - mu) * lax.rsqrt(var + GN_EPS)
    o = o.transpose(0, 2, 1, 3).reshape(B, S, RET_WIDTH)
    return (jax.nn.silu(g.astype(jnp.float32)) * o).astype(g.dtype)


def mla_mixer(c_q, c_kv, k_rope, positions, q_a_norm_g, w_uq, kv_a_norm_g, w_ukv, q_norm_g, k_norm_g):
    B, S, _ = c_q.shape
    q = (rms_norm(c_q, q_a_norm_g) @ w_uq).reshape(B, S, MLA_HEADS, MLA_QK_DIM)
    kv = (rms_norm(c_kv, kv_a_norm_g) @ w_ukv).reshape(B, S, MLA_HEADS, MLA_NOPE_DIM + MLA_V_DIM)
    k_nope, v = kv[..., :MLA_NOPE_DIM], kv[..., MLA_NOPE_DIM:]
    k_pe = jnp.broadcast_to(k_rope[:, :, None, :], (B, S, MLA_HEADS, MLA_ROPE_DIM))
    k = jnp.concatenate([k_nope, k_pe], axis=-1)
    q = rms_norm(q, q_norm_g)
    k = rms_norm(k, k_norm_g)
    q = jnp.concatenate([q[..., :MLA_NOPE_DIM], rotary(q[..., MLA_NOPE_DIM:], positions)], axis=-1)
    k = jnp.concatenate([k[..., :MLA_NOPE_DIM], rotary(k[..., MLA_NOPE_DIM:], positions)], axis=-1)
    scale = MLA_QK_DIM ** -0.5
    n_blocks = S // Q_BLOCK
    q_blocks = q.reshape(B, n_blocks, Q_BLOCK, MLA_HEADS, MLA_QK_DIM).transpose(1, 0, 2, 3, 4)

    def attend(qb):
        s = jnp.einsum('bqhd,bkhd->bhqk', qb, k).astype(jnp.float32) * scale
        p = jax.nn.softmax(s, axis=-1)
        return jnp.einsum('bhqk,bkhd->bqhd', p.astype(v.dtype), v)

    o = lax.map(attend, q_blocks)
    return o.transpose(1, 0, 2, 3, 4).reshape(B, S, MLA_WIDTH)


def swiglu(h, w_gate, w_up, w_down):
    a = jax.nn.silu((h @ w_gate).astype(jnp.float32)).astype(h.dtype)
    return (a * (h @ w_up)) @ w_down


def setup_inputs(seed: int = 0) -> dict:
    key = jax.random.key(seed)
    ks = jax.random.split(key, 20)
    f32 = jnp.float32

    def w(k, shape, fan_in):
        return jax.random.normal(k, shape, f32) * (fan_in ** -0.5)

    def gain(k, shape):
        return jnp.ones(shape, f32) + 0.01 * jax.random.normal(k, shape, f32)

    base_logit = jnp.asarray(np.log(2.0 ** (5 + np.arange(RET_HEADS)) - 1.0), dtype=f32)
    x = jax.random.normal(ks[0], (BATCH, SEQ, D_MODEL), f32)
    offset = jax.random.randint(ks[1], (BATCH, 1), 0, 1024, dtype=jnp.int32)
    positions = (jnp.arange(SEQ, dtype=jnp.int32)[None, :] + offset).astype(jnp.int32)
    return {
        'x': x,
        'positions': positions,
        'norm1_g': gain(ks[2], (DEPTH, D_MODEL)),
        'w_in': w(ks[3], (DEPTH, D_MODEL, IN_WIDTH), D_MODEL),
        'ret_decay_logit_fwd': base_logit[None] + 0.1 * jax.random.normal(ks[4], (DEPTH, RET_HEADS), f32),
        'ret_decay_logit_bwd': base_logit[None] + 0.1 * jax.random.normal(ks[5], (DEPTH, RET_HEADS), f32),
        'q_a_norm_g': gain(ks[6], (DEPTH, MLA_Q_RANK)),
        'w_uq': w(ks[7], (DEPTH, MLA_Q_RANK, MLA_HEADS * MLA_QK_DIM), MLA_Q_RANK),
        'kv_a_norm_g': gain(ks[8], (DEPTH, MLA_KV_RANK)),
        'w_ukv': w(ks[9], (DEPTH, MLA_KV_RANK, MLA_HEADS * (MLA_NOPE_DIM + MLA_V_DIM)), MLA_KV_RANK),
        'q_norm_g': gain(ks[10], (DEPTH, MLA_QK_DIM)),
        'k_norm_g': gain(ks[11], (DEPTH, MLA_QK_DIM)),
        'w_o': w(ks[12], (DEPTH, MIX_WIDTH, D_MODEL), MIX_WIDTH),
        'norm2_g': gain(ks[13], (DEPTH, D_MODEL)),
        'w_gate': w(ks[14], (DEPTH, D_MODEL, D_FF), D_MODEL),
        'w_up': w(ks[15], (DEPTH, D_MODEL, D_FF), D_MODEL),
        'w_down': w(ks[16], (DEPTH, D_FF, D_MODEL), D_FF),
    }


def reference(x, positions, norm1_g, w_in, ret_decay_logit_fwd, ret_decay_logit_bwd, q_a_norm_g, w_uq,
              kv_a_norm_g, w_ukv, q_norm_g, k_norm_g, w_o, norm2_g, w_gate, w_up, w_down):
    split_points = [RET_WIDTH, 2 * RET_WIDTH, 3 * RET_WIDTH, 4 * RET_WIDTH,
                    4 * RET_WIDTH + MLA_Q_RANK, 4 * RET_WIDTH + MLA_Q_RANK + MLA_KV_RANK]
    for layer in range(DEPTH):
        h = rms_norm(x, norm1_g[layer])
        proj = h @ w_in[layer]
        q_r, k_r, v_r, g_r, c_q, c_kv, k_rope = jnp.split(proj, split_points, axis=-1)
        y_ret = retention_mixer(q_r, k_r, v_r, g_r, positions,
                                ret_decay_logit_fwd[layer], ret_decay_logit_bwd[layer])
        y_mla = mla_mixer(c_q, c_kv, k_rope, positions, q_a_norm_g[layer], w_uq[layer],
                          kv_a_norm_g[layer], w_ukv[layer], q_norm_g[layer], k_norm_g[layer])
        x = x + jnp.concatenate([y_ret, y_mla], axis=-1) @ w_o[layer]
        x = x + swiglu(rms_norm(x, norm2_g[layer]), w_gate[layer], w_up[layer], w_down[layer])
    return x
```

```cpp
#include <hip/hip_runtime.h>
#include <hip/hip_cooperative_groups.h>
#include <cstdio>
#include <cstdint>
#include <cmath>
namespace cg = cooperative_groups;
namespace pg8 {
#define PG8_LAS __attribute__((address_space(3)))
typedef unsigned short bf16_t;
typedef short bf16x8 __attribute__((ext_vector_type(8)));
typedef float f32x4 __attribute__((ext_vector_type(4)));
typedef unsigned u32x4 __attribute__((ext_vector_type(4)));
constexpr int BM = 256, BK = 64, HALF = 128, HTB = HALF * BK * 2  , STAGE_BYTES = 8 * HTB, NXCD = 8, WGM = 8;

__host__ __device__ __forceinline__ int lds_byte(int r, int c) { const int st = (r >> 4) * 2 + (c >> 5), rr = r & 15, cc = c & 31, ob = rr * 64 + cc * 2; return st * 1024 + (ob ^ (((ob >> 9) & 1) << 5)); }
__host__ __device__ __forceinline__ void stage_rc(int b, int& R, int& C) { const int st = b / 1024, sb = b % 1024, swz = sb ^ (((sb >> 9) & 1) << 5); R = (st >> 1) * 16 + swz / 64; C = (st & 1) * 32 + (swz % 64) / 2; }
__host__ __device__ __forceinline__ int perm32(int rho) { const int n = rho >> 4, i = rho & 15; return 8 * (i >> 2) + 4 * n + (i & 3); }

struct Unit { int pm, pn; };
struct Gemm { const bf16_t* A; const bf16_t* Bt; int M, N, K; };

struct StaticOrder {
    int nM, nN, nwg, G, c;
    __host__ __device__ void init(int M, int N, int G_, int c_) { nM = M / BM; nN = N / BM; nwg = nM * nN; G = G_; c = c_; }
    __host__ __device__ bool next(int i, Unit& u) const {
        const long L = (long)i * G + c; if (L >= nwg) return false;
        int wgid = (int)L; { const int q = nwg / NXCD, r = nwg % NXCD, xcd = wgid % NXCD, off = wgid / NXCD; wgid = (xcd < r ? xcd * (q + 1) : r * (q + 1) + (xcd - r) * q) + off; }
        const int nig = WGM * nN, gid = wgid / nig, fm = gid * WGM, gsz = (nM - fm) < WGM ? (nM - fm) : WGM;
        u.pm = fm + ((wgid % nig) % gsz); u.pn = (wgid % nig) / gsz; return true;
    }
    __device__ __forceinline__ void a_ready(const Unit&) const {}
    __device__ __forceinline__ void done(const Unit&) const {}
};

__device__ __forceinline__ unsigned cvt_pk_bf16(float lo, float hi) { unsigned r; asm volatile("v_cvt_pk_bf16_f32 %0, %1, %2" : "=v"(r) : "v"(lo), "v"(hi)); return r; }
typedef float f32x2 __attribute__((ext_vector_type(2)));
__device__ __forceinline__ f32x2 gelu_pk(f32x2 v) {
    const f32x2 av = __builtin_elementwise_abs(v), d = av * 0.2316418882f + 1.0f;
    f32x2 t; t.x = __builtin_amdgcn_rcpf(d.x); t.y = __builtin_amdgcn_rcpf(d.y);
    f32x2 q = t * 0.5307027145f + (-0.7265760135f); q = q * t + 0.7107068705f; q = q * t + (-0.142248368f); q = q * t + 0.127414796f; q = q * t;
    const f32x2 s = (v * v) * (-0.72134752044f);
    f32x2 e; e.x = __builtin_amdgcn_exp2f(s.x); e.y = __builtin_amdgcn_exp2f(s.y);
    const f32x2 m = v * (q * e), r = v - m;
    f32x2 o; o.x = v.x < 0.f ? m.x : r.x; o.y = v.y < 0.f ? m.y : r.y; return o;
}

template <int ACT  > struct EpiBf16 {
    static constexpr bool PERM = true, AFTER_DRAIN = false; static_assert(ACT == 0 || ACT == 1, "EpiBf16: ACT is 0 (none) or 1 (gelu_pk)");
    bf16_t* O; int ldc; const float* bias; int split_cols; size_t split_stride; float scale0;
    __device__ __forceinline__ void operator()(const f32x4 (&acc)[2][2][4][2], const Unit& u, int wr, int wc, int fr, int fq) const {
        const int row0 = u.pm * BM + wr * 64 + fr; int colt = u.pn * BM; bf16_t* base = O;
        float sc = 1.f; if (split_cols) { const int t = colt / split_cols; base += (size_t)t * split_stride; colt -= t * split_cols; if (t == 0) sc = scale0; }
        const int col0 = colt + wc * 32 + 8 * fq, bcol0 = u.pn * BM + wc * 32 + 8 * fq;
        f32x4 bv[2][2];
#pragma unroll
        for (int bj = 0; bj < 2; ++bj)
#pragma unroll
            for (int n = 0; n < 2; ++n) bv[bj][n] = bias ? *(const f32x4*)(bias + bcol0 + bj * HALF + 4 * n) : (f32x4){0.f, 0.f, 0.f, 0.f};
#pragma unroll
        for (int ai = 0; ai < 2; ++ai)
#pragma unroll
            for (int m = 0; m < 4; ++m) { bf16_t* rowp = base + (size_t)(row0 + ai * HALF + m * 16) * ldc + col0;
#pragma unroll
                for (int bj = 0; bj < 2; ++bj) { f32x4 v0 = acc[ai][bj][m][0] + bv[bj][0], v1 = acc[ai][bj][m][1] + bv[bj][1];
                    if (ACT == 1) { f32x2 a = gelu_pk((f32x2){v0[0], v0[1]}), b = gelu_pk((f32x2){v0[2], v0[3]}), c = gelu_pk((f32x2){v1[0], v1[1]}), d = gelu_pk((f32x2){v1[2], v1[3]});
                        v0 = (f32x4){a.x, a.y, b.x, b.y}; v1 = (f32x4){c.x, c.y, d.x, d.y}; }
                    v0 = v0 * sc; v1 = v1 * sc; u32x4 w; w.x = cvt_pk_bf16(v0[0], v0[1]); w.y = cvt_pk_bf16(v0[2], v0[3]); w.z = cvt_pk_bf16(v1[0], v1[1]); w.w = cvt_pk_bf16(v1[2], v1[3]);
                    *(u32x4*)(rowp + bj * HALF) = w; } }
    }
};
typedef unsigned u32x2 __attribute__((ext_vector_type(2)));
struct EpiResid {
    static constexpr bool PERM = false, AFTER_DRAIN = false; static constexpr int LANE_T = 0;
    const float* base; float* out; bf16_t* xb; float* ssq; int ldc;
    __device__ __forceinline__ void operator()(const f32x4 (&acc)[2][2][4][2], const Unit& u, int wr, int wc, int fr, int fq) const {
        const int col0 = u.pn * BM + wc * 32 + 4 * fq;
#pragma unroll
        for (int ai = 0; ai < 2; ++ai)
#pragma unroll
            for (int m = 0; m < 4; ++m) { const int r = u.pm * BM + ai * HALF + wr * 64 + m * 16 + fr; const size_t off = (size_t)r * ldc + col0; float s = 0.f;
#pragma unroll
                for (int bj = 0; bj < 2; ++bj)
#pragma unroll
                    for (int n = 0; n < 2; ++n) { const f32x4 bs = *(const f32x4*)(base + off + bj * HALF + n * 16); const f32x4 o = bs + acc[ai][bj][m][n];
                        *(f32x4*)(out + off + bj * HALF + n * 16) = o; u32x2 w; w.x = cvt_pk_bf16(o[0], o[1]); w.y = cvt_pk_bf16(o[2], o[3]);
                        *(u32x2*)(xb + off + bj * HALF + n * 16) = w; s += (o[0] * o[0] + o[1] * o[1]) + (o[2] * o[2] + o[3] * o[3]); }
                s += __shfl_xor(s, 16); s += __shfl_xor(s, 32);
                if (fq == 0) ssq[(size_t)r * 16 + u.pn * 4 + wc] = s; }
    }
};
struct EpiSwiGLU {
    static constexpr bool PERM = true, AFTER_DRAIN = false; static constexpr int LANE_T = 0;
    bf16_t* O; int ldc; const float* ssq; float inv_d, eps;
    __device__ __forceinline__ void operator()(const f32x4 (&acc)[2][2][4][2], const Unit& u, int wr, int wc, int fr, int fq) const {
        const int col0 = u.pn * HALF + wc * 32 + 8 * fq;
#pragma unroll
        for (int ai = 0; ai < 2; ++ai)
#pragma unroll
            for (int m = 0; m < 4; ++m) { const int r = u.pm * BM + ai * HALF + wr * 64 + m * 16 + fr;
                const f32x4* sp = (const f32x4*)(ssq + (size_t)r * 16); const f32x4 a = sp[0], b = sp[1], c = sp[2], d = sp[3];
                const float ss = ((a[0] + a[1]) + (a[2] + a[3])) + ((b[0] + b[1]) + (b[2] + b[3])) + ((c[0] + c[1]) + (c[2] + c[3])) + ((d[0] + d[1]) + (d[2] + d[3]));
                const float rstd = 1.0f / sqrtf(ss * inv_d + eps);
                float v[8];
#pragma unroll
                for (int n = 0; n < 2; ++n)
#pragma unroll
                    for (int e = 0; e < 4; ++e) { const float g = acc[ai][0][m][n][e] * rstd, up = acc[ai][1][m][n][e] * rstd;
                        const float sg = g * __builtin_amdgcn_rcpf(1.0f + __builtin_amdgcn_exp2f(-1.4426950408889634f * g)); v[n * 4 + e] = sg * up; }
                u32x4 w; w.x = cvt_pk_bf16(v[0], v[1]); w.y = cvt_pk_bf16(v[2], v[3]); w.z = cvt_pk_bf16(v[4], v[5]); w.w = cvt_pk_bf16(v[6], v[7]);
                *(u32x4*)(O + (size_t)r * ldc + col0) = w; }
    }
};
struct EpiAccOut {
    static constexpr bool PERM = false, AFTER_DRAIN = false; static constexpr int LANE_T = 0;
    float* out; int ldc;
    __device__ __forceinline__ void operator()(const f32x4 (&acc)[2][2][4][2], const Unit& u, int wr, int wc, int fr, int fq) const {
        const int col0 = u.pn * BM + wc * 32 + 4 * fq;
#pragma unroll
        for (int ai = 0; ai < 2; ++ai)
#pragma unroll
            for (int m = 0; m < 4; ++m) { float* rowp = out + (size_t)(u.pm * BM + ai * HALF + wr * 64 + m * 16 + fr) * ldc + col0;
#pragma unroll
                for (int bj = 0; bj < 2; ++bj)
#pragma unroll
                    for (int n = 0; n < 2; ++n) { const f32x4 bs = *(const f32x4*)(rowp + bj * HALF + n * 16); *(f32x4*)(rowp + bj * HALF + n * 16) = bs + acc[ai][bj][m][n]; } }
    }
};

struct EpiProj {
    static constexpr bool PERM = true, AFTER_DRAIN = false; static constexpr int LANE_T = 0;
    bf16_t* O; int ldc; const float* rot;
    __device__ __forceinline__ void operator()(const f32x4 (&acc)[2][2][4][2], const Unit& u, int wr, int wc, int fr, int fq) const {
        const int row0 = u.pm * BM + wr * 64 + fr;
        if (u.pn < 4) {
            const float ksc = (u.pn >= 2) ? 0.125f : 1.0f; const int col_lo = u.pn * BM + wc * 64 + 8 * fq;
#pragma unroll
            for (int ai = 0; ai < 2; ++ai)
#pragma unroll
                for (int m = 0; m < 4; ++m) { const int r = row0 + ai * HALF + m * 16; const f32x4* rp = (const f32x4*)(rot + ((size_t)r * 32 + 8 * fq) * 2); bf16_t* rowp = O + (size_t)r * ldc + col_lo;
                    const f32x4 c0 = rp[0], c1 = rp[1], c2 = rp[2], c3 = rp[3];
                    const f32x4 a0 = acc[ai][0][m][0], a1 = acc[ai][0][m][1], b0 = acc[ai][1][m][0], b1 = acc[ai][1][m][1];
                    float lo[8], hi[8];
                    lo[0] = a0[0] * c0[0] - b0[0] * c0[1]; hi[0] = b0[0] * c0[0] + a0[0] * c0[1]; lo[1] = a0[1] * c0[2] - b0[1] * c0[3]; hi[1] = b0[1] * c0[2] + a0[1] * c0[3];
                    lo[2] = a0[2] * c1[0] - b0[2] * c1[1]; hi[2] = b0[2] * c1[0] + a0[2] * c1[1]; lo[3] = a0[3] * c1[2] - b0[3] * c1[3]; hi[3] = b0[3] * c1[2] + a0[3] * c1[3];
                    lo[4] = a1[0] * c2[0] - b1[0] * c2[1]; hi[4] = b1[0] * c2[0] + a1[0] * c2[1]; lo[5] = a1[1] * c2[2] - b1[1] * c2[3]; hi[5] = b1[1] * c2[2] + a1[1] * c2[3];
                    lo[6] = a1[2] * c3[0] - b1[2] * c3[1]; hi[6] = b1[2] * c3[0] + a1[2] * c3[1]; lo[7] = a1[3] * c3[2] - b1[3] * c3[3]; hi[7] = b1[3] * c3[2] + a1[3] * c3[3];
                    u32x4 w; w.x = cvt_pk_bf16(lo[0] * ksc, lo[1] * ksc); w.y = cvt_pk_bf16(lo[2] * ksc, lo[3] * ksc); w.z = cvt_pk_bf16(lo[4] * ksc, lo[5] * ksc); w.w = cvt_pk_bf16(lo[6] * ksc, lo[7] * ksc);
                    *(u32x4*)rowp = w;
                    w.x = cvt_pk_bf16(hi[0] * ksc, hi[1] * ksc); w.y = cvt_pk_bf16(hi[2] * ksc, hi[3] * ksc); w.z = cvt_pk_bf16(hi[4] * ksc, hi[5] * ksc); w.w = cvt_pk_bf16(hi[6] * ksc, hi[7] * ksc);
                    *(u32x4*)(rowp + 32) = w; }
        } else {
            const int col0 = u.pn * BM + wc * 32 + 8 * fq;
#pragma unroll
            for (int ai = 0; ai < 2; ++ai)
#pragma unroll
                for (int m = 0; m < 4; ++m) { bf16_t* rowp = O + (size_t)(row0 + ai * HALF + m * 16) * ldc + col0;
#pragma unroll
                    for (int bj = 0; bj < 2; ++bj) { const f32x4 v0 = acc[ai][bj][m][0], v1 = acc[ai][bj][m][1];
                        u32x4 w; w.x = cvt_pk_bf16(v0[0], v0[1]); w.y = cvt_pk_bf16(v0[2], v0[3]); w.z = cvt_pk_bf16(v1[0], v1[1]); w.w = cvt_pk_bf16(v1[2], v1[3]);
                        *(u32x4*)(rowp + bj * HALF) = w; } }
        }
    }
};

#define PG8_FENCE() asm volatile("" ::: "memory")
struct EpiResid2 {
    static constexpr bool PERM = false, AFTER_DRAIN = false; static constexpr int LANE_T = 0;
    const float* base; bf16_t* xb; float* ssq; int ldc;
    __device__ __forceinline__ void operator()(const f32x4 (&acc)[2][2][4][2], const Unit& u, int wr, int wc, int fr, int fq) const {
        const int col0 = u.pn * BM + wc * 32 + 4 * fq; const int rowb = u.pm * BM + wr * 64 + fr;
        f32x4 b0[4], b1[4], b2[4];
#define PG8_R2_LOAD(B, g) do { const float* p_ = base + (size_t)(rowb + ((g) >> 2) * HALF + ((g) & 3) * 16) * ldc + col0; B[0] = *(const f32x4*)(p_); B[1] = *(const f32x4*)(p_ + 16); B[2] = *(const f32x4*)(p_ + HALF); B[3] = *(const f32x4*)(p_ + HALF + 16); } while (0)
#define PG8_R2_PROC(B, g) do { const int ai_ = (g) >> 2, m_ = (g) & 3; const int r_ = rowb + ai_ * HALF + m_ * 16; bf16_t* q_ = xb + (size_t)r_ * ldc + col0; float s_ = 0.f; \
            _Pragma("unroll") for (int bj = 0; bj < 2; ++bj) _Pragma("unroll") for (int n = 0; n < 2; ++n) { const f32x4 o = B[bj * 2 + n] + acc[ai_][bj][m_][n]; \
                u32x2 w; w.x = cvt_pk_bf16(o[0], o[1]); w.y = cvt_pk_bf16(o[2], o[3]); *(u32x2*)(q_ + bj * HALF + n * 16) = w; s_ += (o[0] * o[0] + o[1] * o[1]) + (o[2] * o[2] + o[3] * o[3]); } \
            s_ += __shfl_xor(s_, 16); s_ += __shfl_xor(s_, 32); if (fq == 0) ssq[(size_t)r_ * 16 + u.pn * 4 + wc] = s_; } while (0)
        PG8_R2_LOAD(b0, 0); PG8_R2_LOAD(b1, 1); PG8_FENCE();
        PG8_R2_LOAD(b2, 2); PG8_FENCE(); PG8_R2_PROC(b0, 0); PG8_FENCE();
        PG8_R2_LOAD(b0, 3); PG8_FENCE(); PG8_R2_PROC(b1, 1); PG8_FENCE();
        PG8_R2_LOAD(b1, 4); PG8_FENCE(); PG8_R2_PROC(b2, 2); PG8_FENCE();
        PG8_R2_LOAD(b2, 5); PG8_FENCE(); PG8_R2_PROC(b0, 3); PG8_FENCE();
        PG8_R2_LOAD(b0, 6); PG8_FENCE(); PG8_R2_PROC(b1, 4); PG8_FENCE();
        PG8_R2_LOAD(b1, 7); PG8_FENCE(); PG8_R2_PROC(b2, 5); PG8_FENCE();
        PG8_R2_PROC(b0, 6); PG8_FENCE(); PG8_R2_PROC(b1, 7);
#undef PG8_R2_LOAD
#undef PG8_R2_PROC
    }
};
struct EpiSwiGLU2 {
    static constexpr bool PERM = true, AFTER_DRAIN = false; static constexpr int LANE_T = 0;
    bf16_t* O; int ldc; const float* rstd;
    __device__ __forceinline__ void operator()(const f32x4 (&acc)[2][2][4][2], const Unit& u, int wr, int wc, int fr, int fq) const {
        const int col0 = u.pn * HALF + wc * 32 + 8 * fq; const int rowb = u.pm * BM + wr * 64 + fr;
        float rs[8];
#pragma unroll
        for (int g = 0; g < 8; ++g) rs[g] = rstd[rowb + (g >> 2) * HALF + (g & 3) * 16];
        PG8_FENCE();
#pragma unroll
        for (int g = 0; g < 8; ++g) { const int ai = g >> 2, m = g & 3; const float r_ = rs[g], c1 = -1.4426950408889634f * r_, r2 = r_ * r_; float v[8];
#pragma unroll
            for (int n = 0; n < 2; ++n)
#pragma unroll
                for (int e = 0; e < 4; ++e) { const float gt = acc[ai][0][m][n][e], up = acc[ai][1][m][n][e];
                    v[n * 4 + e] = (gt * up) * (r2 * __builtin_amdgcn_rcpf(1.0f + __builtin_amdgcn_exp2f(gt * c1))); }
            u32x4 w; w.x = cvt_pk_bf16(v[0], v[1]); w.y = cvt_pk_bf16(v[2], v[3]); w.z = cvt_pk_bf16(v[4], v[5]); w.w = cvt_pk_bf16(v[6], v[7]);
            *(u32x4*)(O + (size_t)(rowb + ai * HALF + m * 16) * ldc + col0) = w; }
    }
};
struct EpiOut2 {
    static constexpr bool PERM = false, AFTER_DRAIN = false; static constexpr int LANE_T = 0;
    const bf16_t* xb; float* out; int ldc;
    __device__ __forceinline__ void operator()(const f32x4 (&acc)[2][2][4][2], const Unit& u, int wr, int wc, int fr, int fq) const {
        const int col0 = u.pn * BM + wc * 32 + 4 * fq; const int rowb = u.pm * BM + wr * 64 + fr;
        u32x2 xr[8][4];
#pragma unroll
        for (int g = 0; g < 8; ++g) { const bf16_t* p_ = xb + (size_t)(rowb + (g >> 2) * HALF + (g & 3) * 16) * ldc + col0;
            xr[g][0] = *(const u32x2*)(p_); xr[g][1] = *(const u32x2*)(p_ + 16); xr[g][2] = *(const u32x2*)(p_ + HALF); xr[g][3] = *(const u32x2*)(p_ + HALF + 16); }
        PG8_FENCE();
#pragma unroll
        for (int g = 0; g < 8; ++g) { const int ai = g >> 2, m = g & 3; float* q_ = out + (size_t)(rowb + ai * HALF + m * 16) * ldc + col0;
#pragma unroll
            for (int bj = 0; bj < 2; ++bj)
#pragma unroll
                for (int n = 0; n < 2; ++n) { const u32x2 w = xr[g][bj * 2 + n]; f32x4 b;
                    b[0] = __builtin_bit_cast(float, w.x << 16); b[1] = __builtin_bit_cast(float, w.x & 0xffff0000u); b[2] = __builtin_bit_cast(float, w.y << 16); b[3] = __builtin_bit_cast(float, w.y & 0xffff0000u);
                    *(f32x4*)(q_ + bj * HALF + n * 16) = b + acc[ai][bj][m][n]; } }
    }
};
struct EpiProj2 {
    static constexpr bool PERM = true, AFTER_DRAIN = false; static constexpr int LANE_T = 0;
    bf16_t* O; int ldc; const float* rot;
    __device__ __forceinline__ void operator()(const f32x4 (&acc)[2][2][4][2], const Unit& u, int wr, int wc, int fr, int fq) const {
        const int row0 = u.pm * BM + wr * 64 + fr;
        if (u.pn < 4) {
            const float ksc = (u.pn >= 2) ? 0.125f : 1.0f; const int col_lo = u.pn * BM + wc * 64 + 8 * fq;
            f32x4 c0_[4], c1_[4], c2_[4];
#define PG8_P2_LOAD(C, g) do { const f32x4* rp_ = (const f32x4*)(rot + ((size_t)(row0 + ((g) >> 2) * HALF + ((g) & 3) * 16) * 32 + 8 * fq) * 2); C[0] = rp_[0]; C[1] = rp_[1]; C[2] = rp_[2]; C[3] = rp_[3]; } while (0)
#define PG8_P2_PROC(C, g) do { const int ai_ = (g) >> 2, m_ = (g) & 3; bf16_t* rowp = O + (size_t)(row0 + ai_ * HALF + m_ * 16) * ldc + col_lo; \
                const f32x4 a0 = acc[ai_][0][m_][0], a1 = acc[ai_][0][m_][1], b0 = acc[ai_][1][m_][0], b1 = acc[ai_][1][m_][1]; float lo[8], hi[8]; \
                lo[0] = a0[0] * C[0][0] - b0[0] * C[0][1]; hi[0] = b0[0] * C[0][0] + a0[0] * C[0][1]; lo[1] = a0[1] * C[0][2] - b0[1] * C[0][3]; hi[1] = b0[1] * C[0][2] + a0[1] * C[0][3]; \
                lo[2] = a0[2] * C[1][0] - b0[2] * C[1][1]; hi[2] = b0[2] * C[1][0] + a0[2] * C[1][1]; lo[3] = a0[3] * C[1][2] - b0[3] * C[1][3]; hi[3] = b0[3] * C[1][2] + a0[3] * C[1][3]; \
                lo[4] = a1[0] * C[2][0] - b1[0] * C[2][1]; hi[4] = b1[0] * C[2][0] + a1[0] * C[2][1]; lo[5] = a1[1] * C[2][2] - b1[1] * C[2][3]; hi[5] = b1[1] * C[2][2] + a1[1] * C[2][3]; \
                lo[6] = a1[2] * C[3][0] - b1[2] * C[3][1]; hi[6] = b1[2] * C[3][0] + a1[2] * C[3][1]; lo[7] = a1[3] * C[3][2] - b1[3] * C[3][3]; hi[7] = b1[3] * C[3][2] + a1[3] * C[3][3]; \
                u32x4 w; w.x = cvt_pk_bf16(lo[0] * ksc, lo[1] * ksc); w.y = cvt_pk_bf16(lo[2] * ksc, lo[3] * ksc); w.z = cvt_pk_bf16(lo[4] * ksc, lo[5] * ksc); w.w = cvt_pk_bf16(lo[6] * ksc, lo[7] * ksc); \
                *(u32x4*)rowp = w; \
                w.x = cvt_pk_bf16(hi[0] * ksc, hi[1] * ksc); w.y = cvt_pk_bf16(hi[2] * ksc, hi[3] * ksc); w.z = cvt_pk_bf16(hi[4] * ksc, hi[5] * ksc); w.w = cvt_pk_bf16(hi[6] * ksc, hi[7] * ksc); \
                *(u32x4*)(rowp + 32) = w; } while (0)
            PG8_P2_LOAD(c0_, 0); PG8_P2_LOAD(c1_, 1); PG8_FENCE();
            PG8_P2_LOAD(c2_, 2); PG8_FENCE(); PG8_P2_PROC(c0_, 0); PG8_FENCE();
            PG8_P2_LOAD(c0_, 3); PG8_FENCE(); PG8_P2_PROC(c1_, 1); PG8_FENCE();
            PG8_P2_LOAD(c1_, 4); PG8_FENCE(); PG8_P2_PROC(c2_, 2); PG8_FENCE();
            PG8_P2_LOAD(c2_, 5); PG8_FENCE(); PG8_P2_PROC(c0_, 3); PG8_FENCE();
            PG8_P2_LOAD(c0_, 6); PG8_FENCE(); PG8_P2_PROC(c1_, 4); PG8_FENCE();
            PG8_P2_LOAD(c1_, 7); PG8_FENCE(); PG8_P2_PROC(c2_, 5); PG8_FENCE();
            PG8_P2_PROC(c0_, 6); PG8_FENCE(); PG8_P2_PROC(c1_, 7);
#undef PG8_P2_LOAD
#undef PG8_P2_PROC
        } else {
            const int col0 = u.pn * BM + wc * 32 + 8 * fq;
#pragma unroll
            for (int ai = 0; ai < 2; ++ai)
#pragma unroll
                for (int m = 0; m < 4; ++m) { bf16_t* rowp = O + (size_t)(row0 + ai * HALF + m * 16) * ldc + col0;
#pragma unroll
                    for (int bj = 0; bj < 2; ++bj) { const f32x4 v0 = acc[ai][bj][m][0], v1 = acc[ai][bj][m][1];
                        u32x4 w; w.x = cvt_pk_bf16(v0[0], v0[1]); w.y = cvt_pk_bf16(v0[2], v0[3]); w.z = cvt_pk_bf16(v1[0], v1[1]); w.w = cvt_pk_bf16(v1[2], v1[3]);
                        *(u32x4*)(rowp + bj * HALF) = w; } }
        }
    }
};

__device__ __forceinline__ float oct_sum(float v) {
    v += __int_as_float(__builtin_amdgcn_update_dpp(0, __float_as_int(v), 0xB1, 0xf, 0xf, false));
    v += __int_as_float(__builtin_amdgcn_update_dpp(0, __float_as_int(v), 0x4E, 0xf, 0xf, false));
    v += __int_as_float(__builtin_amdgcn_update_dpp(0, __float_as_int(v), 0x141, 0xf, 0xf, false));
    return v;
}
struct EpiOut5 {
    static constexpr bool PERM = false, AFTER_DRAIN = false; static constexpr int LANE_T = 2;
    const bf16_t* xb; float* out; int ldc;
    __device__ __forceinline__ void operator()(const f32x4 (&acc)[2][2][4][2], const Unit& u, int wr, int wc, int rr, int c) const {
        const int col0 = u.pn * BM + wc * 32 + 4 * c; const int rowb = u.pm * BM + wr * 64 + rr;
        u32x2 xr[8][4];
#pragma unroll
        for (int g = 0; g < 8; ++g) { const bf16_t* p_ = xb + (size_t)(rowb + (g >> 2) * HALF + (g & 3) * 16) * ldc + col0;
            xr[g][0] = *(const u32x2*)(p_); xr[g][1] = *(const u32x2*)(p_ + 8 * (size_t)ldc); xr[g][2] = *(const u32x2*)(p_ + HALF); xr[g][3] = *(const u32x2*)(p_ + 8 * (size_t)ldc + HALF); }
        PG8_FENCE();
#pragma unroll
        for (int g = 0; g < 8; ++g) { const int ai = g >> 2, m = g & 3; float* q_ = out + (size_t)(rowb + ai * HALF + m * 16) * ldc + col0;
#pragma unroll
            for (int bj = 0; bj < 2; ++bj)
#pragma unroll
                for (int I = 0; I < 2; ++I) { const u32x2 w = xr[g][bj * 2 + I]; f32x4 b;
                    b[0] = __builtin_bit_cast(float, w.x << 16); b[1] = __builtin_bit_cast(float, w.x & 0xffff0000u); b[2] = __builtin_bit_cast(float, w.y << 16); b[3] = __builtin_bit_cast(float, w.y & 0xffff0000u);
                    *(f32x4*)(q_ + (size_t)(8 * I) * ldc + bj * HALF) = b + acc[ai][bj][m][I]; } }
    }
};
struct EpiResid5 {
    static constexpr bool PERM = false, AFTER_DRAIN = false; static constexpr int LANE_T = 2;
    const float* base; bf16_t* xb; float* ssq; int ldc;
    __device__ __forceinline__ void operator()(const f32x4 (&acc)[2][2][4][2], const Unit& u, int wr, int wc, int rr, int c) const {
        const int col0 = u.pn * BM + wc * 32 + 4 * c; const int rowb = u.pm * BM + wr * 64 + rr;
        f32x4 b0[4], b1[4], b2[4];
#define PG8_R5_LOAD(B, g) do { const float* p_ = base + (size_t)(rowb + ((g) >> 2) * HALF + ((g) & 3) * 16) * ldc + col0; B[0] = *(const f32x4*)(p_); B[1] = *(const f32x4*)(p_ + 8 * (size_t)ldc); B[2] = *(const f32x4*)(p_ + HALF); B[3] = *(const f32x4*)(p_ + 8 * (size_t)ldc + HALF); } while (0)
#define PG8_R5_PROC(B, g) do { const int ai_ = (g) >> 2, m_ = (g) & 3; const int r_ = rowb + ai_ * HALF + m_ * 16; bf16_t* q_ = xb + (size_t)r_ * ldc + col0; \
            _Pragma("unroll") for (int I = 0; I < 2; ++I) { float s_ = 0.f; \
                _Pragma("unroll") for (int bj = 0; bj < 2; ++bj) { const f32x4 o = B[bj * 2 + I] + acc[ai_][bj][m_][I]; \
                    u32x2 w; w.x = cvt_pk_bf16(o[0], o[1]); w.y = cvt_pk_bf16(o[2], o[3]); *(u32x2*)(q_ + (size_t)(8 * I) * ldc + bj * HALF) = w; s_ += (o[0] * o[0] + o[1] * o[1]) + (o[2] * o[2] + o[3] * o[3]); } \
                s_ = oct_sum(s_); if (c == 0) ssq[(size_t)(r_ + 8 * I) * 16 + u.pn * 4 + wc] = s_; } } while (0)
        PG8_R5_LOAD(b0, 0); PG8_R5_LOAD(b1, 1); PG8_FENCE();
        PG8_R5_LOAD(b2, 2); PG8_FENCE(); PG8_R5_PROC(b0, 0); PG8_FENCE();
        PG8_R5_LOAD(b0, 3); PG8_FENCE(); PG8_R5_PROC(b1, 1); PG8_FENCE();
        PG8_R5_LOAD(b1, 4); PG8_FENCE(); PG8_R5_PROC(b2, 2); PG8_FENCE();
        PG8_R5_LOAD(b2, 5); PG8_FENCE(); PG8_R5_PROC(b0, 3); PG8_FENCE();
        PG8_R5_LOAD(b0, 6); PG8_FENCE(); PG8_R5_PROC(b1, 4); PG8_FENCE();
        PG8_R5_LOAD(b1, 7); PG8_FENCE(); PG8_R5_PROC(b2, 5); PG8_FENCE();
        PG8_R5_PROC(b0, 6); PG8_FENCE(); PG8_R5_PROC(b1, 7);
#undef PG8_R5_LOAD
#undef PG8_R5_PROC
    }
};

struct EpiProj3 {
    static constexpr bool PERM = true, AFTER_DRAIN = false; static constexpr int LANE_T = 0;
    bf16_t* O; int ldc; const int* pos;
    __device__ __forceinline__ void operator()(const f32x4 (&acc)[2][2][4][2], const Unit& u, int wr, int wc, int fr, int fq) const {
        const int row0 = u.pm * BM + wr * 64 + fr;
        if (u.pn < 4) {
            const float ksc = (u.pn >= 2) ? 0.125f : 1.0f; const int col_lo = u.pn * BM + wc * 64 + 8 * fq;
            f32x4 c0_[4], c1_[4], c2_[4];
            float inv[8]; int pp[8];
#pragma unroll
            for (int jj = 0; jj < 8; ++jj) inv[jj] = __builtin_amdgcn_exp2f(-(float)(8 * fq + jj) * (13.287712379549449f / 32.0f));
#pragma unroll
            for (int g = 0; g < 8; ++g) pp[g] = pos[row0 + (g >> 2) * HALF + (g & 3) * 16];
            PG8_FENCE();
#define PG8_P2_LOAD(C, g) do { const float p_ = (float)pp[g]; _Pragma("unroll") for (int jj = 0; jj < 8; ++jj) { const float ang_ = p_ * inv[jj]; const float rev_ = ang_ * 0.15915494f; \
                const float x_ = __builtin_amdgcn_fractf(rev_) + (__builtin_fmaf(ang_, 0.15915494f, -rev_) + ang_ * 6.4206383e-9f);     \
                C[jj >> 1][(jj & 1) * 2] = __builtin_amdgcn_cosf(x_); C[jj >> 1][(jj & 1) * 2 + 1] = __builtin_amdgcn_sinf(x_); } } while (0)
#define PG8_P2_PROC(C, g) do { const int ai_ = (g) >> 2, m_ = (g) & 3; bf16_t* rowp = O + (size_t)(row0 + ai_ * HALF + m_ * 16) * ldc + col_lo; \
                const f32x4 a0 = acc[ai_][0][m_][0], a1 = acc[ai_][0][m_][1], b0 = acc[ai_][1][m_][0], b1 = acc[ai_][1][m_][1]; float lo[8], hi[8]; \
                lo[0] = a0[0] * C[0][0] - b0[0] * C[0][1]; hi[0] = b0[0] * C[0][0] + a0[0] * C[0][1]; lo[1] = a0[1] * C[0][2] - b0[1] * C[0][3]; hi[1] = b0[1] * C[0][2] + a0[1] * C[0][3]; \
                lo[2] = a0[2] * C[1][0] - b0[2] * C[1][1]; hi[2] = b0[2] * C[1][0] + a0[2] * C[1][1]; lo[3] = a0[3] * C[1][2] - b0[3] * C[1][3]; hi[3] = b0[3] * C[1][2] + a0[3] * C[1][3]; \
                lo[4] = a1[0] * C[2][0] - b1[0] * C[2][1]; hi[4] = b1[0] * C[2][0] + a1[0] * C[2][1]; lo[5] = a1[1] * C[2][2] - b1[1] * C[2][3]; hi[5] = b1[1] * C[2][2] + a1[1] * C[2][3]; \
                lo[6] = a1[2] * C[3][0] - b1[2] * C[3][1]; hi[6] = b1[2] * C[3][0] + a1[2] * C[3][1]; lo[7] = a1[3] * C[3][2] - b1[3] * C[3][3]; hi[7] = b1[3] * C[3][2] + a1[3] * C[3][3]; \
                u32x4 w; w.x = cvt_pk_bf16(lo[0] * ksc, lo[1] * ksc); w.y = cvt_pk_bf16(lo[2] * ksc, lo[3] * ksc); w.z = cvt_pk_bf16(lo[4] * ksc, lo[5] * ksc); w.w = cvt_pk_bf16(lo[6] * ksc, lo[7] * ksc); \
                *(u32x4*)rowp = w; \
                w.x = cvt_pk_bf16(hi[0] * ksc, hi[1] * ksc); w.y = cvt_pk_bf16(hi[2] * ksc, hi[3] * ksc); w.z = cvt_pk_bf16(hi[4] * ksc, hi[5] * ksc); w.w = cvt_pk_bf16(hi[6] * ksc, hi[7] * ksc); \
                *(u32x4*)(rowp + 32) = w; } while (0)
            PG8_P2_LOAD(c0_, 0); PG8_P2_LOAD(c1_, 1); PG8_FENCE();
            PG8_P2_LOAD(c2_, 2); PG8_FENCE(); PG8_P2_PROC(c0_, 0); PG8_FENCE();
            PG8_P2_LOAD(c0_, 3); PG8_FENCE(); PG8_P2_PROC(c1_, 1); PG8_FENCE();
            PG8_P2_LOAD(c1_, 4); PG8_FENCE(); PG8_P2_PROC(c2_, 2); PG8_FENCE();
            PG8_P2_LOAD(c2_, 5); PG8_FENCE(); PG8_P2_PROC(c0_, 3); PG8_FENCE();
            PG8_P2_LOAD(c0_, 6); PG8_FENCE(); PG8_P2_PROC(c1_, 4); PG8_FENCE();
            PG8_P2_LOAD(c1_, 7); PG8_FENCE(); PG8_P2_PROC(c2_, 5); PG8_FENCE();
            PG8_P2_PROC(c0_, 6); PG8_FENCE(); PG8_P2_PROC(c1_, 7);
#undef PG8_P2_LOAD
#undef PG8_P2_PROC
        } else {
            const int col0 = u.pn * BM + wc * 32 + 8 * fq;
#pragma unroll
            for (int ai = 0; ai < 2; ++ai)
#pragma unroll
                for (int m = 0; m < 4; ++m) { bf16_t* rowp = O + (size_t)(row0 + ai * HALF + m * 16) * ldc + col0;
#pragma unroll
                    for (int bj = 0; bj < 2; ++bj) { const f32x4 v0 = acc[ai][bj][m][0], v1 = acc[ai][bj][m][1];
                        u32x4 w; w.x = cvt_pk_bf16(v0[0], v0[1]); w.y = cvt_pk_bf16(v0[2], v0[3]); w.z = cvt_pk_bf16(v1[0], v1[1]); w.w = cvt_pk_bf16(v1[2], v1[3]);
                        *(u32x4*)(rowp + bj * HALF) = w; } }
        }
    }
};

__device__ __forceinline__ void lane_exchange(f32x4 (&acc)[2][2][4][2], int lane) {
    const bool hi_ = (lane & 8) != 0; const int rr_ = lane >> 3, c_ = lane & 7; const int pa = (rr_ + 8 * (c_ >> 2) + 16 * (c_ & 3)) << 2;
#pragma unroll
    for (int a = 0; a < 2; ++a)
#pragma unroll
        for (int b = 0; b < 2; ++b)
#pragma unroll
            for (int m = 0; m < 4; ++m)
#pragma unroll
                for (int e = 0; e < 4; ++e) { const float a0 = acc[a][b][m][0][e], a1 = acc[a][b][m][1][e]; const float snd = hi_ ? a0 : a1;
                    const float rcv = __int_as_float(__builtin_amdgcn_update_dpp(0, __float_as_int(snd), 0x128, 0xf, 0xf, false));
                    const float d0 = hi_ ? rcv : a0, d1 = hi_ ? a1 : rcv;
                    acc[a][b][m][0][e] = __int_as_float(__builtin_amdgcn_ds_bpermute(pa, __float_as_int(d0))); acc[a][b][m][1][e] = __int_as_float(__builtin_amdgcn_ds_bpermute(pa, __float_as_int(d1))); }
}
struct EpiOut6 {
    static constexpr bool PERM = false, AFTER_DRAIN = false; static constexpr int LANE_T = 3;
    const bf16_t* xb; float* out; int ldc;
    __device__ __forceinline__ void run(f32x4 (&acc)[2][2][4][2], const Unit& u, int wr, int wc, int lane) const {
        const int rr = lane >> 3, c = lane & 7;
        const int col0 = u.pn * BM + wc * 32 + 4 * c; const int rowb = u.pm * BM + wr * 64 + rr;
        u32x2 xr[8][4];
#pragma unroll
        for (int g = 0; g < 8; ++g) { const bf16_t* p_ = xb + (size_t)(rowb + (g >> 2) * HALF + (g & 3) * 16) * ldc + col0;
            xr[g][0] = *(const u32x2*)(p_); xr[g][1] = *(const u32x2*)(p_ + 8 * (size_t)ldc); xr[g][2] = *(const u32x2*)(p_ + HALF); xr[g][3] = *(const u32x2*)(p_ + 8 * (size_t)ldc + HALF); }
        PG8_FENCE();
        lane_exchange(acc, lane);
        PG8_FENCE();
#pragma unroll
        for (int g = 0; g < 8; ++g) { const int ai = g >> 2, m = g & 3; float* q_ = out + (size_t)(rowb + ai * HALF + m * 16) * ldc + col0;
#pragma unroll
            for (int bj = 0; bj < 2; ++bj)
#pragma unroll
                for (int I = 0; I < 2; ++I) { const u32x2 w = xr[g][bj * 2 + I]; f32x4 b;
                    b[0] = __builtin_bit_cast(float, w.x << 16); b[1] = __builtin_bit_cast(float, w.x & 0xffff0000u); b[2] = __builtin_bit_cast(float, w.y << 16); b[3] = __builtin_bit_cast(float, w.y & 0xffff0000u);
                    *(f32x4*)(q_ + (size_t)(8 * I) * ldc + bj * HALF) = b + acc[ai][bj][m][I]; } }
    }
};
struct EpiResid6 {
    static constexpr bool PERM = false, AFTER_DRAIN = false; static constexpr int LANE_T = 3;
    const float* base; bf16_t* xb; float* ssq; int ldc;
    __device__ __forceinline__ void run(f32x4 (&acc)[2][2][4][2], const Unit& u, int wr, int wc, int lane) const {
        const int rr = lane >> 3, c = lane & 7;
        const int col0 = u.pn * BM + wc * 32 + 4 * c; const int rowb = u.pm * BM + wr * 64 + rr;
        f32x4 b0[4], b1[4], b2[4];
#define PG8_R5_LOAD(B, g) do { const float* p_ = base + (size_t)(rowb + ((g) >> 2) * HALF + ((g) & 3) * 16) * ldc + col0; B[0] = *(const f32x4*)(p_); B[1] = *(const f32x4*)(p_ + 8 * (size_t)ldc); B[2] = *(const f32x4*)(p_ + HALF); B[3] = *(const f32x4*)(p_ + 8 * (size_t)ldc + HALF); } while (0)
#define PG8_R5_PROC(B, g) do { const int ai_ = (g) >> 2, m_ = (g) & 3; const int r_ = rowb + ai_ * HALF + m_ * 16; bf16_t* q_ = xb + (size_t)r_ * ldc + col0; \
            _Pragma("unroll") for (int I = 0; I < 2; ++I) { float s_ = 0.f; \
                _Pragma("unroll") for (int bj = 0; bj < 2; ++bj) { const f32x4 o = B[bj * 2 + I] + acc[ai_][bj][m_][I]; \
                    u32x2 w; w.x = cvt_pk_bf16(o[0], o[1]); w.y = cvt_pk_bf16(o[2], o[3]); *(u32x2*)(q_ + (size_t)(8 * I) * ldc + bj * HALF) = w; s_ += (o[0] * o[0] + o[1] * o[1]) + (o[2] * o[2] + o[3] * o[3]); } \
                s_ = oct_sum(s_); if (c == 0) ssq[(size_t)(r_ + 8 * I) * 16 + u.pn * 4 + wc] = s_; } } while (0)
        PG8_R5_LOAD(b0, 0); PG8_R5_LOAD(b1, 1); PG8_FENCE();
        lane_exchange(acc, lane);
        PG8_FENCE(); PG8_R5_LOAD(b2, 2); PG8_FENCE(); PG8_R5_PROC(b0, 0); PG8_FENCE();
        PG8_R5_LOAD(b0, 3); PG8_FENCE(); PG8_R5_PROC(b1, 1); PG8_FENCE();
        PG8_R5_LOAD(b1, 4); PG8_FENCE(); PG8_R5_PROC(b2, 2); PG8_FENCE();
        PG8_R5_LOAD(b2, 5); PG8_FENCE(); PG8_R5_PROC(b0, 3); PG8_FENCE();
        PG8_R5_LOAD(b0, 6); PG8_FENCE(); PG8_R5_PROC(b1, 4); PG8_FENCE();
        PG8_R5_LOAD(b1, 7); PG8_FENCE(); PG8_R5_PROC(b2, 5); PG8_FENCE();
        PG8_R5_PROC(b0, 6); PG8_FENCE(); PG8_R5_PROC(b1, 7);
#undef PG8_R5_LOAD
#undef PG8_R5_PROC
    }
};

struct EpiSwiGLU2N {
    static constexpr bool PERM = true, AFTER_DRAIN = false; static constexpr int LANE_T = 0;
    bf16_t* O; int ldc; const float* rstd;
    __device__ __forceinline__ void operator()(const f32x4 (&acc)[2][2][4][2], const Unit& u, int wr, int wc, int fr, int fq) const {
        const int col0 = u.pn * HALF + wc * 32 + 8 * fq; const int rowb = u.pm * BM + wr * 64 + fr;
        float rs[8];
#pragma unroll
        for (int g = 0; g < 8; ++g) rs[g] = rstd[rowb + (g >> 2) * HALF + (g & 3) * 16];
        PG8_FENCE();
#pragma unroll
        for (int g = 0; g < 8; ++g) { const int ai = g >> 2, m = g & 3; const float r_ = rs[g], c1 = -1.4426950408889634f * r_, r2 = r_ * r_; float v[8];
#pragma unroll
            for (int n = 0; n < 2; ++n)
#pragma unroll
                for (int e = 0; e < 4; ++e) { const float gt = acc[ai][0][m][n][e], up = acc[ai][1][m][n][e];
                    v[n * 4 + e] = (gt * up) * (r2 * __builtin_amdgcn_rcpf(1.0f + __builtin_amdgcn_exp2f(gt * c1))); }
            u32x4 w; w.x = cvt_pk_bf16(v[0], v[1]); w.y = cvt_pk_bf16(v[2], v[3]); w.z = cvt_pk_bf16(v[4], v[5]); w.w = cvt_pk_bf16(v[6], v[7]);
            __builtin_nontemporal_store(w, (u32x4*)(O + (size_t)(rowb + ai * HALF + m * 16) * ldc + col0)); }
    }
};
struct EpiProj3N {
    static constexpr bool PERM = true, AFTER_DRAIN = false; static constexpr int LANE_T = 0;
    bf16_t* O; int ldc; const int* pos;
    __device__ __forceinline__ void operator()(const f32x4 (&acc)[2][2][4][2], const Unit& u, int wr, int wc, int fr, int fq) const {
        const int row0 = u.pm * BM + wr * 64 + fr;
        if (u.pn < 4) {
            const float ksc = (u.pn >= 2) ? 0.125f : 1.0f; const int col_lo = u.pn * BM + wc * 64 + 8 * fq;
            f32x4 c0_[4], c1_[4], c2_[4];
            float inv[8]; int pp[8];
#pragma unroll
            for (int jj = 0; jj < 8; ++jj) inv[jj] = __builtin_amdgcn_exp2f(-(float)(8 * fq + jj) * (13.287712379549449f / 32.0f));
#pragma unroll
            for (int g = 0; g < 8; ++g) pp[g] = pos[row0 + (g >> 2) * HALF + (g & 3) * 16];
            PG8_FENCE();
#define PG8_P2_LOAD(C, g) do { const float p_ = (float)pp[g]; _Pragma("unroll") for (int jj = 0; jj < 8; ++jj) { const float ang_ = p_ * inv[jj]; const float rev_ = ang_ * 0.15915494f; \
                const float x_ = __builtin_amdgcn_fractf(rev_) + (__builtin_fmaf(ang_, 0.15915494f, -rev_) + ang_ * 6.4206383e-9f);     \
                C[jj >> 1][(jj & 1) * 2] = __builtin_amdgcn_cosf(x_); C[jj >> 1][(jj & 1) * 2 + 1] = __builtin_amdgcn_sinf(x_); } } while (0)
#define PG8_P2_PROC(C, g) do { const int ai_ = (g) >> 2, m_ = (g) & 3; bf16_t* rowp = O + (size_t)(row0 + ai_ * HALF + m_ * 16) * ldc + col_lo; \
                const f32x4 a0 = acc[ai_][0][m_][0], a1 = acc[ai_][0][m_][1], b0 = acc[ai_][1][m_][0], b1 = acc[ai_][1][m_][1]; float lo[8], hi[8]; \
                lo[0] = a0[0] * C[0][0] - b0[0] * C[0][1]; hi[0] = b0[0] * C[0][0] + a0[0] * C[0][1]; lo[1] = a0[1] * C[0][2] - b0[1] * C[0][3]; hi[1] = b0[1] * C[0][2] + a0[1] * C[0][3]; \
                lo[2] = a0[2] * C[1][0] - b0[2] * C[1][1]; hi[2] = b0[2] * C[1][0] + a0[2] * C[1][1]; lo[3] = a0[3] * C[1][2] - b0[3] * C[1][3]; hi[3] = b0[3] * C[1][2] + a0[3] * C[1][3]; \
                lo[4] = a1[0] * C[2][0] - b1[0] * C[2][1]; hi[4] = b1[0] * C[2][0] + a1[0] * C[2][1]; lo[5] = a1[1] * C[2][2] - b1[1] * C[2][3]; hi[5] = b1[1] * C[2][2] + a1[1] * C[2][3]; \
                lo[6] = a1[2] * C[3][0] - b1[2] * C[3][1]; hi[6] = b1[2] * C[3][0] + a1[2] * C[3][1]; lo[7] = a1[3] * C[3][2] - b1[3] * C[3][3]; hi[7] = b1[3] * C[3][2] + a1[3] * C[3][3]; \
                u32x4 w; w.x = cvt_pk_bf16(lo[0] * ksc, lo[1] * ksc); w.y = cvt_pk_bf16(lo[2] * ksc, lo[3] * ksc); w.z = cvt_pk_bf16(lo[4] * ksc, lo[5] * ksc); w.w = cvt_pk_bf16(lo[6] * ksc, lo[7] * ksc); \
                __builtin_nontemporal_store(w, (u32x4*)rowp); \
                w.x = cvt_pk_bf16(hi[0] * ksc, hi[1] * ksc); w.y = cvt_pk_bf16(hi[2] * ksc, hi[3] * ksc); w.z = cvt_pk_bf16(hi[4] * ksc, hi[5] * ksc); w.w = cvt_pk_bf16(hi[6] * ksc, hi[7] * ksc); \
                __builtin_nontemporal_store(w, (u32x4*)(rowp + 32)); } while (0)
            PG8_P2_LOAD(c0_, 0); PG8_P2_LOAD(c1_, 1); PG8_FENCE();
            PG8_P2_LOAD(c2_, 2); PG8_FENCE(); PG8_P2_PROC(c0_, 0); PG8_FENCE();
            PG8_P2_LOAD(c0_, 3); PG8_FENCE(); PG8_P2_PROC(c1_, 1); PG8_FENCE();
            PG8_P2_LOAD(c1_, 4); PG8_FENCE(); PG8_P2_PROC(c2_, 2); PG8_FENCE();
            PG8_P2_LOAD(c2_, 5); PG8_FENCE(); PG8_P2_PROC(c0_, 3); PG8_FENCE();
            PG8_P2_LOAD(c0_, 6); PG8_FENCE(); PG8_P2_PROC(c1_, 4); PG8_FENCE();
            PG8_P2_LOAD(c1_, 7); PG8_FENCE(); PG8_P2_PROC(c2_, 5); PG8_FENCE();
            PG8_P2_PROC(c0_, 6); PG8_FENCE(); PG8_P2_PROC(c1_, 7);
#undef PG8_P2_LOAD
#undef PG8_P2_PROC
        } else {
            const int col0 = u.pn * BM + wc * 32 + 8 * fq;
#pragma unroll
            for (int ai = 0; ai < 2; ++ai)
#pragma unroll
                for (int m = 0; m < 4; ++m) { bf16_t* rowp = O + (size_t)(row0 + ai * HALF + m * 16) * ldc + col0;
#pragma unroll
                    for (int bj = 0; bj < 2; ++bj) { const f32x4 v0 = acc[ai][bj][m][0], v1 = acc[ai][bj][m][1];
                        u32x4 w; w.x = cvt_pk_bf16(v0[0], v0[1]); w.y = cvt_pk_bf16(v0[2], v0[3]); w.z = cvt_pk_bf16(v1[0], v1[1]); w.w = cvt_pk_bf16(v1[2], v1[3]);
                        __builtin_nontemporal_store(w, (u32x4*)(rowp + bj * HALF)); } }
        }
    }
};

struct EpiOut6N {
    static constexpr bool PERM = false, AFTER_DRAIN = false; static constexpr int LANE_T = 3;
    const bf16_t* xb; float* out; int ldc;
    __device__ __forceinline__ void run(f32x4 (&acc)[2][2][4][2], const Unit& u, int wr, int wc, int lane) const {
        const int rr = lane >> 3, c = lane & 7;
        const int col0 = u.pn * BM + wc * 32 + 4 * c; const int rowb = u.pm * BM + wr * 64 + rr;
        u32x2 xr[8][4];
#pragma unroll
        for (int g = 0; g < 8; ++g) { const bf16_t* p_ = xb + (size_t)(rowb + (g >> 2) * HALF + (g & 3) * 16) * ldc + col0;
            xr[g][0] = *(const u32x2*)(p_); xr[g][1] = *(const u32x2*)(p_ + 8 * (size_t)ldc); xr[g][2] = *(const u32x2*)(p_ + HALF); xr[g][3] = *(const u32x2*)(p_ + 8 * (size_t)ldc + HALF); }
        PG8_FENCE();
        lane_exchange(acc, lane);
        PG8_FENCE();
#pragma unroll
        for (int g = 0; g < 8; ++g) { const int ai = g >> 2, m = g & 3; float* q_ = out + (size_t)(rowb + ai * HALF + m * 16) * ldc + col0;
#pragma unroll
            for (int bj = 0; bj < 2; ++bj)
#pragma unroll
                for (int I = 0; I < 2; ++I) { const u32x2 w = xr[g][bj * 2 + I]; f32x4 b;
                    b[0] = __builtin_bit_cast(float, w.x << 16); b[1] = __builtin_bit_cast(float, w.x & 0xffff0000u); b[2] = __builtin_bit_cast(float, w.y << 16); b[3] = __builtin_bit_cast(float, w.y & 0xffff0000u);
                    __builtin_nontemporal_store(b + acc[ai][bj][m][I], (f32x4*)(q_ + (size_t)(8 * I) * ldc + bj * HALF)); } }
    }
};

struct EpiOut6L {
    static constexpr bool PERM = false, AFTER_DRAIN = false; static constexpr int LANE_T = 3;
    const bf16_t* xb; float* out; int ldc;
    __device__ __forceinline__ void run(f32x4 (&acc)[2][2][4][2], const Unit& u, int wr, int wc, int lane) const {
        const int rr = lane >> 3, c = lane & 7;
        const int col0 = u.pn * BM + wc * 32 + 4 * c; const int rowb = u.pm * BM + wr * 64 + rr;
        u32x2 xr[8][4];
#pragma unroll
        for (int g = 0; g < 8; ++g) { const bf16_t* p_ = xb + (size_t)(rowb + (g >> 2) * HALF + (g & 3) * 16) * ldc + col0;
            xr[g][0] = __builtin_nontemporal_load((const u32x2*)(p_)); xr[g][1] = __builtin_nontemporal_load((const u32x2*)(p_ + 8 * (size_t)ldc)); xr[g][2] = __builtin_nontemporal_load((const u32x2*)(p_ + HALF)); xr[g][3] = __builtin_nontemporal_load((const u32x2*)(p_ + 8 * (size_t)ldc + HALF)); }
        PG8_FENCE();
        lane_exchange(acc, lane);
        PG8_FENCE();
#pragma unroll
        for (int g = 0; g < 8; ++g) { const int ai = g >> 2, m = g & 3; float* q_ = out + (size_t)(rowb + ai * HALF + m * 16) * ldc + col0;
#pragma unroll
            for (int bj = 0; bj < 2; ++bj)
#pragma unroll
                for (int I = 0; I < 2; ++I) { const u32x2 w = xr[g][bj * 2 + I]; f32x4 b;
                    b[0] = __builtin_bit_cast(float, w.x << 16); b[1] = __builtin_bit_cast(float, w.x & 0xffff0000u); b[2] = __builtin_bit_cast(float, w.y << 16); b[3] = __builtin_bit_cast(float, w.y & 0xffff0000u);
                    *(f32x4*)(q_ + (size_t)(8 * I) * ldc + bj * HALF) = b + acc[ai][bj][m][I]; } }
    }
};
struct EpiResid6L {
    static constexpr bool PERM = false, AFTER_DRAIN = false; static constexpr int LANE_T = 3;
    const float* base; bf16_t* xb; float* ssq; int ldc;
    __device__ __forceinline__ void run(f32x4 (&acc)[2][2][4][2], const Unit& u, int wr, int wc, int lane) const {
        const int rr = lane >> 3, c = lane & 7;
        const int col0 = u.pn * BM + wc * 32 + 4 * c; const int rowb = u.pm * BM + wr * 64 + rr;
        f32x4 b0[4], b1[4], b2[4];
#define PG8_R5_LOAD(B, g) do { const float* p_ = base + (size_t)(rowb + ((g) >> 2) * HALF + ((g) & 3) * 16) * ldc + col0; B[0] = __builtin_nontemporal_load((const f32x4*)(p_)); B[1] = __builtin_nontemporal_load((const f32x4*)(p_ + 8 * (size_t)ldc)); B[2] = __builtin_nontemporal_load((const f32x4*)(p_ + HALF)); B[3] = __builtin_nontemporal_load((const f32x4*)(p_ + 8 * (size_t)ldc + HALF)); } while (0)
#define PG8_R5_PROC(B, g) do { const int ai_ = (g) >> 2, m_ = (g) & 3; const int r_ = rowb + ai_ * HALF + m_ * 16; bf16_t* q_ = xb + (size_t)r_ * ldc + col0; \
            _Pragma("unroll") for (int I = 0; I < 2; ++I) { float s_ = 0.f; \
                _Pragma("unroll") for (int bj = 0; bj < 2; ++bj) { const f32x4 o = B[bj * 2 + I] + acc[ai_][bj][m_][I]; \
                    u32x2 w; w.x = cvt_pk_bf16(o[0], o[1]); w.y = cvt_pk_bf16(o[2], o[3]); *(u32x2*)(q_ + (size_t)(8 * I) * ldc + bj * HALF) = w; s_ += (o[0] * o[0] + o[1] * o[1]) + (o[2] * o[2] + o[3] * o[3]); } \
                s_ = oct_sum(s_); if (c == 0) ssq[(size_t)(r_ + 8 * I) * 16 + u.pn * 4 + wc] = s_; } } while (0)
        PG8_R5_LOAD(b0, 0); PG8_R5_LOAD(b1, 1); PG8_FENCE();
        lane_exchange(acc, lane);
        PG8_FENCE(); PG8_R5_LOAD(b2, 2); PG8_FENCE(); PG8_R5_PROC(b0, 0); PG8_FENCE();
        PG8_R5_LOAD(b0, 3); PG8_FENCE(); PG8_R5_PROC(b1, 1); PG8_FENCE();
        PG8_R5_LOAD(b1, 4); PG8_FENCE(); PG8_R5_PROC(b2, 2); PG8_FENCE();
        PG8_R5_LOAD(b2, 5); PG8_FENCE(); PG8_R5_PROC(b0, 3); PG8_FENCE();
        PG8_R5_LOAD(b0, 6); PG8_FENCE(); PG8_R5_PROC(b1, 4); PG8_FENCE();
        PG8_R5_LOAD(b1, 7); PG8_FENCE(); PG8_R5_PROC(b2, 5); PG8_FENCE();
        PG8_R5_PROC(b0, 6); PG8_FENCE(); PG8_R5_PROC(b1, 7);
#undef PG8_R5_LOAD
#undef PG8_R5_PROC
    }
};

struct EpiResid7 {
    static constexpr bool PERM = false, AFTER_DRAIN = false; static constexpr int LANE_T = 3;
    const float* base; bf16_t* xb; float* ssq; int ldc;
    __device__ __forceinline__ void run(f32x4 (&acc)[2][2][4][2], const Unit& u, int wr, int wc, int lane) const {
        const int rr = lane >> 3, c = lane & 7;
        const int col0 = u.pn * BM + wc * 32 + 4 * c; const int rowb = u.pm * BM + wr * 64 + rr;
        f32x4 b0[4], b1[4], b2[4];
        float k0_ = 0.f, k1_ = 0.f;
#define PG8_R5_LOAD(B, g) do { const float* p_ = base + (size_t)(rowb + ((g) >> 2) * HALF + ((g) & 3) * 16) * ldc + col0; B[0] = __builtin_nontemporal_load((const f32x4*)(p_)); B[1] = __builtin_nontemporal_load((const f32x4*)(p_ + 8 * (size_t)ldc)); B[2] = __builtin_nontemporal_load((const f32x4*)(p_ + HALF)); B[3] = __builtin_nontemporal_load((const f32x4*)(p_ + 8 * (size_t)ldc + HALF)); } while (0)
#define PG8_R5_PROC(B, g) do { const int ai_ = (g) >> 2, m_ = (g) & 3; const int r_ = rowb + ai_ * HALF + m_ * 16; bf16_t* q_ = xb + (size_t)r_ * ldc + col0; \
            _Pragma("unroll") for (int I = 0; I < 2; ++I) { float s_ = 0.f; \
                _Pragma("unroll") for (int bj = 0; bj < 2; ++bj) { const f32x4 o = B[bj * 2 + I] + acc[ai_][bj][m_][I]; \
                    u32x2 w; w.x = cvt_pk_bf16(o[0], o[1]); w.y = cvt_pk_bf16(o[2], o[3]); *(u32x2*)(q_ + (size_t)(8 * I) * ldc + bj * HALF) = w; s_ += (o[0] * o[0] + o[1] * o[1]) + (o[2] * o[2] + o[3] * o[3]); } \
                s_ = oct_sum(s_); if ((2 * (g) + I) < 8) { k0_ = (c == ((2 * (g) + I) & 7)) ? s_ : k0_; } else { k1_ = (c == ((2 * (g) + I) & 7)) ? s_ : k1_; } } } while (0)
        PG8_R5_LOAD(b0, 0); PG8_R5_LOAD(b1, 1); PG8_FENCE();
        lane_exchange(acc, lane);
        PG8_FENCE(); PG8_R5_LOAD(b2, 2); PG8_FENCE(); PG8_R5_PROC(b0, 0); PG8_FENCE();
        PG8_R5_LOAD(b0, 3); PG8_FENCE(); PG8_R5_PROC(b1, 1); PG8_FENCE();
        PG8_R5_LOAD(b1, 4); PG8_FENCE(); PG8_R5_PROC(b2, 2); PG8_FENCE();
        PG8_R5_LOAD(b2, 5); PG8_FENCE(); PG8_R5_PROC(b0, 3); PG8_FENCE();
        PG8_R5_LOAD(b0, 6); PG8_FENCE(); PG8_R5_PROC(b1, 4); PG8_FENCE();
        PG8_R5_LOAD(b1, 7); PG8_FENCE(); PG8_R5_PROC(b2, 5); PG8_FENCE();
        PG8_R5_PROC(b0, 6); PG8_FENCE(); PG8_R5_PROC(b1, 7);
        { const int rw_ = rowb + (c >> 1) * 16 + 8 * (c & 1); ssq[(size_t)rw_ * 16 + u.pn * 4 + wc] = k0_; ssq[(size_t)(rw_ + HALF) * 16 + u.pn * 4 + wc] = k1_; }
#undef PG8_R5_LOAD
#undef PG8_R5_PROC
    }
};

struct EpiProj4 {
    static constexpr bool PERM = true, AFTER_DRAIN = false; static constexpr int LANE_T = 0;
    bf16_t* O; int ldc; const int* pos;
    __device__ __forceinline__ void operator()(const f32x4 (&acc)[2][2][4][2], const Unit& u, int wr, int wc, int fr, int fq) const {
        const int row0 = u.pm * BM + wr * 64 + fr;
        if (u.pn < 4) {
            const float ksc = (u.pn >= 2) ? 0.125f : 1.0f; const int col_lo = u.pn * BM + wc * 64 + 8 * fq;
            f32x4 c0_[4], c1_[4], c2_[4];
            float inv[8]; int pp[8];
#pragma unroll
            for (int jj = 0; jj < 8; ++jj) inv[jj] = __builtin_amdgcn_exp2f(-(float)(8 * fq + jj) * (13.287712379549449f / 32.0f));
#pragma unroll
            for (int g = 0; g < 8; ++g) pp[g] = pos[row0 + (g >> 2) * HALF + (g & 3) * 16];
            PG8_FENCE();
#define PG8_P2_LOAD(C, g) do { const float p_ = (float)pp[g]; _Pragma("unroll") for (int jj = 0; jj < 8; ++jj) { const float ang_ = p_ * inv[jj]; const float rev_ = ang_ * 0.15915494f; \
                const float x_ = __builtin_amdgcn_fractf(rev_) + (__builtin_fmaf(ang_, 0.15915494f, -rev_) + ang_ * 6.4206383e-9f);     \
                C[jj >> 1][(jj & 1) * 2] = __builtin_amdgcn_cosf(x_); C[jj >> 1][(jj & 1) * 2 + 1] = __builtin_amdgcn_sinf(x_); } } while (0)
#define PG8_P2_PROC(C, g) do { const int ai_ = (g) >> 2, m_ = (g) & 3; bf16_t* rowp = O + (size_t)(row0 + ai_ * HALF + m_ * 16) * ldc + col_lo; \
                const f32x4 a0 = acc[ai_][0][m_][0], a1 = acc[ai_][0][m_][1], b0 = acc[ai_][1][m_][0], b1 = acc[ai_][1][m_][1]; float lo[8], hi[8]; \
                lo[0] = a0[0] * C[0][0] - b0[0] * C[0][1]; hi[0] = b0[0] * C[0][0] + a0[0] * C[0][1]; lo[1] = a0[1] * C[0][2] - b0[1] * C[0][3]; hi[1] = b0[1] * C[0][2] + a0[1] * C[0][3]; \
                lo[2] = a0[2] * C[1][0] - b0[2] * C[1][1]; hi[2] = b0[2] * C[1][0] + a0[2] * C[1][1]; lo[3] = a0[3] * C[1][2] - b0[3] * C[1][3]; hi[3] = b0[3] * C[1][2] + a0[3] * C[1][3]; \
                lo[4] = a1[0] * C[2][0] - b1[0] * C[2][1]; hi[4] = b1[0] * C[2][0] + a1[0] * C[2][1]; lo[5] = a1[1] * C[2][2] - b1[1] * C[2][3]; hi[5] = b1[1] * C[2][2] + a1[1] * C[2][3]; \
                lo[6] = a1[2] * C[3][0] - b1[2] * C[3][1]; hi[6] = b1[2] * C[3][0] + a1[2] * C[3][1]; lo[7] = a1[3] * C[3][2] - b1[3] * C[3][3]; hi[7] = b1[3] * C[3][2] + a1[3] * C[3][3]; \
                u32x4 w; w.x = cvt_pk_bf16(lo[0] * ksc, lo[1] * ksc); w.y = cvt_pk_bf16(lo[2] * ksc, lo[3] * ksc); w.z = cvt_pk_bf16(lo[4] * ksc, lo[5] * ksc); w.w = cvt_pk_bf16(lo[6] * ksc, lo[7] * ksc); \
                *(u32x4*)rowp = w; \
                w.x = cvt_pk_bf16(hi[0] * ksc, hi[1] * ksc); w.y = cvt_pk_bf16(hi[2] * ksc, hi[3] * ksc); w.z = cvt_pk_bf16(hi[4] * ksc, hi[5] * ksc); w.w = cvt_pk_bf16(hi[6] * ksc, hi[7] * ksc); \
                *(u32x4*)(rowp + 32) = w; } while (0)
            PG8_P2_LOAD(c0_, 0); PG8_P2_LOAD(c1_, 1); PG8_FENCE();
            PG8_P2_LOAD(c2_, 2); PG8_FENCE(); PG8_P2_PROC(c0_, 0); PG8_FENCE();
            PG8_P2_LOAD(c0_, 3); PG8_FENCE(); PG8_P2_PROC(c1_, 1); PG8_FENCE();
            PG8_P2_LOAD(c1_, 4); PG8_FENCE(); PG8_P2_PROC(c2_, 2); PG8_FENCE();
            PG8_P2_LOAD(c2_, 5); PG8_FENCE(); PG8_P2_PROC(c0_, 3); PG8_FENCE();
            PG8_P2_LOAD(c0_, 6); PG8_FENCE(); PG8_P2_PROC(c1_, 4); PG8_FENCE();
            PG8_P2_LOAD(c1_, 7); PG8_FENCE(); PG8_P2_PROC(c2_, 5); PG8_FENCE();
            PG8_P2_PROC(c0_, 6); PG8_FENCE(); PG8_P2_PROC(c1_, 7);
#undef PG8_P2_LOAD
#undef PG8_P2_PROC
        } else {
            const int col0 = u.pn * BM + wc * 32 + 8 * fq;
#pragma unroll
            for (int ai = 0; ai < 2; ++ai)
#pragma unroll
                for (int m = 0; m < 4; ++m) { bf16_t* rowp = O + (size_t)(row0 + ai * HALF + m * 16) * ldc + col0;
#pragma unroll
                    for (int bj = 0; bj < 2; ++bj) { const f32x4 v0 = acc[ai][bj][m][0], v1 = acc[ai][bj][m][1];
                        u32x4 w; w.x = cvt_pk_bf16(v0[0], v0[1]); w.y = cvt_pk_bf16(v0[2], v0[3]); w.z = cvt_pk_bf16(v1[0], v1[1]); w.w = cvt_pk_bf16(v1[2], v1[3]);
                        if (!(u.pn == 9 && bj == 1 && wc > 0)) *(u32x4*)(rowp + bj * HALF) = w; } }
        }
    }
};

struct EpiSwiGLU3 {
    static constexpr bool PERM = true, AFTER_DRAIN = false; static constexpr int LANE_T = 0;
    bf16_t* O; int ldc; const PG8_LAS int* plist; const PG8_LAS float* rtab;
    __device__ __forceinline__ void operator()(const f32x4 (&acc)[2][2][4][2], const Unit& u, int wr, int wc, int fr, int fq) const {
        const int col0 = u.pn * HALF + wc * 32 + 8 * fq; const int rowb = u.pm * BM + wr * 64 + fr;
        int slot = 0; { const int n = plist[0]; for (int k = 1; k < n; ++k) if (plist[1 + k] == u.pm) slot = k; }
        const PG8_LAS float* rp = rtab + slot * 256 + wr * 64 + fr;
        float rs[8];
#pragma unroll
        for (int g = 0; g < 8; ++g) rs[g] = rp[(g >> 2) * HALF + (g & 3) * 16];
#pragma unroll
        for (int g = 0; g < 8; ++g) { const int ai = g >> 2, m = g & 3; const float r_ = rs[g], c1 = -1.4426950408889634f * r_, r2 = r_ * r_; float v[8];
#pragma unroll
            for (int n = 0; n < 2; ++n)
#pragma unroll
                for (int e = 0; e < 4; ++e) { const float gt = acc[ai][0][m][n][e], up = acc[ai][1][m][n][e];
                    v[n * 4 + e] = (gt * up) * (r2 * __builtin_amdgcn_rcpf(1.0f + __builtin_amdgcn_exp2f(gt * c1))); }
            u32x4 w; w.x = cvt_pk_bf16(v[0], v[1]); w.y = cvt_pk_bf16(v[2], v[3]); w.z = cvt_pk_bf16(v[4], v[5]); w.w = cvt_pk_bf16(v[6], v[7]);
            __builtin_nontemporal_store(w, (u32x4*)(O + (size_t)(rowb + ai * HALF + m * 16) * ldc + col0)); }
    }
};
template <class Epi, class Sched, bool ALIGN_EPI = false, bool SP2 = false>
__device__ __forceinline__ void gemm_phase(PG8_LAS unsigned char* lds, const Gemm g, const Sched& S, const Epi& E) {
    int tid_ = threadIdx.x; asm volatile("" : "+v"(tid_));
    const int tid = tid_, wid = __builtin_amdgcn_readfirstlane(tid >> 6), lane = tid & 63, wr = wid >> 2, wc = wid & 3, fr = lane & 15, fq = lane >> 4;
    const int K = g.K, nt = K / BK;
    unsigned voffA[2], voffB[2];
#pragma unroll
    for (int i = 0; i < 2; ++i) { int R, C; stage_rc(tid * 16 + i * 8192, R, C); const int Rb = Epi::PERM ? ((R & ~31) + perm32(R & 31)) : R;
        voffA[i] = (unsigned)(R * K + C) * 2u; voffB[i] = (unsigned)(Rb * K + C) * 2u; }
    const size_t kstep = (size_t)(BK * 2);
    const size_t hstep = (size_t)HALF * K * 2;
    const size_t tstep = 2 * hstep;
    const unsigned ldsw = (unsigned)wid * 1024u;
    const int aoff = lds_byte(wr * 64 + fr, fq * 8), boff = lds_byte(wc * 32 + fr, fq * 8);
#define PG8_SA(b, h) (((b) * 2 + (h)) * HTB)
#define PG8_SB(b, h) ((4 + (b) * 2 + (h)) * HTB)
#define PG8_STAGE(bufoff, gbase, voff) do { _Pragma("unroll") for (int _i = 0; _i < 2; ++_i) \
        __builtin_amdgcn_global_load_lds((const unsigned*)((const char*)(gbase) + (voff)[_i]), (PG8_LAS unsigned*)(lds + (bufoff) + ldsw + _i * 8192), 16, 0, 0); } while (0)
#define PG8_LDA(dst, b, h) do { _Pragma("unroll") for (int m = 0; m < 4; ++m) _Pragma("unroll") for (int k = 0; k < 2; ++k) dst[m][k] = *(const PG8_LAS bf16x8*)(lds + PG8_SA(b, h) + aoff + m * 2048 + k * 1024); } while (0)
#define PG8_LDB(dst, b, h) do { _Pragma("unroll") for (int n = 0; n < 2; ++n) _Pragma("unroll") for (int k = 0; k < 2; ++k) dst[n][k] = *(const PG8_LAS bf16x8*)(lds + PG8_SB(b, h) + boff + n * 2048 + k * 1024); } while (0)
#define PG8_MMA(ai, bj, At, Bt) do { __builtin_amdgcn_s_setprio(1); _Pragma("unroll") for (int m = 0; m < 4; ++m) _Pragma("unroll") for (int n = 0; n < 2; ++n) _Pragma("unroll") for (int k = 0; k < 2; ++k) \
        acc[ai][bj][m][n] = __builtin_amdgcn_mfma_f32_16x16x32_bf16(Bt[n][k], At[m][k], acc[ai][bj][m][n], 0, 0, 0); __builtin_amdgcn_s_setprio(0); } while (0)
#define PG8_WAIT_V(n) asm volatile("s_waitcnt vmcnt(" #n ")" ::: "memory")
#define PG8_WAIT_L(n) asm volatile("s_waitcnt lgkmcnt(" #n ")" ::: "memory")
#define PG8_BAR __builtin_amdgcn_s_barrier()
#define PG8_SCHED __builtin_amdgcn_sched_barrier(0)
    Unit cur, nxt; int ui = 0;
    if (!S.next(0, cur)) return;
    f32x4 acc[2][2][4][2];
#pragma unroll
    for (int a = 0; a < 2; ++a)
#pragma unroll
        for (int b = 0; b < 2; ++b)
#pragma unroll
            for (int m = 0; m < 4; ++m)
#pragma unroll
                for (int n = 0; n < 2; ++n) acc[a][b][m][n] = (f32x4){0.f, 0.f, 0.f, 0.f};
    bf16x8 At[4][2], B0[2][2], B1[2][2];
    const char* cA = (const char*)g.A + (size_t)cur.pm * tstep; const char* cB = (const char*)g.Bt + (size_t)cur.pn * tstep;
    S.a_ready(cur);
    if constexpr (SP2) {
        PG8_STAGE(PG8_SB(0, 0), cB, voffB); PG8_STAGE(PG8_SB(0, 1), cB + hstep, voffB); PG8_STAGE(PG8_SA(0, 0), cA, voffA); PG8_STAGE(PG8_SA(0, 1), cA + hstep, voffA);
        if (wr == 1) PG8_BAR;
        PG8_WAIT_V(2); PG8_BAR;
        PG8_STAGE(PG8_SB(1, 0), cB + kstep, voffB); PG8_STAGE(PG8_SA(1, 0), cA + kstep, voffA); PG8_STAGE(PG8_SB(1, 1), cB + hstep + kstep, voffB);
        PG8_WAIT_V(6); PG8_BAR;
    } else {
        PG8_STAGE(PG8_SB(0, 0), cB, voffB); PG8_STAGE(PG8_SA(0, 0), cA, voffA); PG8_STAGE(PG8_SB(0, 1), cB + hstep, voffB); PG8_STAGE(PG8_SA(0, 1), cA + hstep, voffA);
        if (wr == 1) PG8_BAR;
        PG8_WAIT_V(4); PG8_BAR;
        PG8_STAGE(PG8_SB(1, 0), cB + kstep, voffB); PG8_STAGE(PG8_SA(1, 0), cA + kstep, voffA); PG8_STAGE(PG8_SB(1, 1), cB + hstep + kstep, voffB);
        PG8_WAIT_V(6); PG8_BAR;
    }
    for (;;) {
        const bool has_next = S.next(ui + 1, nxt);
        const char* nA = has_next ? (const char*)g.A + (size_t)nxt.pm * tstep : cA; const char* nB = has_next ? (const char*)g.Bt + (size_t)nxt.pn * tstep : cB;
        for (int t = 0; t < nt; t += 2) {
            const bool last = (t == nt - 2);
            const char* a1 = cA + (size_t)(t + 1) * kstep;
            const char* a2 = last ? nA : cA + (size_t)(t + 2) * kstep; const char* b2 = last ? nB : cB + (size_t)(t + 2) * kstep;
            const char* a3 = a2 + kstep; const char* b3 = b2 + kstep;
            if (last && has_next) S.a_ready(nxt);
            if constexpr (SP2) {
            PG8_LDB(B0, 0, 0); PG8_LDB(B1, 0, 1); PG8_SCHED; PG8_LDA(At, 0, 0); PG8_STAGE(PG8_SA(1, 1), a1 + hstep, voffA);
            PG8_WAIT_V(8); PG8_WAIT_L(0); PG8_BAR; PG8_MMA(0, 0, At, B0); PG8_MMA(0, 1, At, B1); PG8_BAR; PG8_SCHED;
            PG8_LDA(At, 0, 1); PG8_STAGE(PG8_SB(0, 0), b2, voffB); PG8_STAGE(PG8_SB(0, 1), b2 + hstep, voffB); PG8_STAGE(PG8_SA(0, 0), a2, voffA);
            PG8_WAIT_V(8); PG8_WAIT_L(0); PG8_BAR; PG8_MMA(1, 0, At, B0); PG8_MMA(1, 1, At, B1); PG8_BAR; PG8_SCHED;
            PG8_LDB(B0, 1, 0); PG8_LDB(B1, 1, 1); PG8_SCHED; PG8_LDA(At, 1, 0); PG8_STAGE(PG8_SA(0, 1), a2 + hstep, voffA);
            PG8_WAIT_V(8); PG8_WAIT_L(0); PG8_BAR; PG8_MMA(0, 0, At, B0); PG8_MMA(0, 1, At, B1); PG8_BAR; PG8_SCHED;
            PG8_LDA(At, 1, 1); PG8_STAGE(PG8_SB(1, 0), b3, voffB); PG8_STAGE(PG8_SB(1, 1), b3 + hstep, voffB); PG8_STAGE(PG8_SA(1, 0), a3, voffA);
            PG8_WAIT_V(8); PG8_WAIT_L(0); PG8_BAR; PG8_MMA(1, 0, At, B0); PG8_MMA(1, 1, At, B1); PG8_BAR; PG8_SCHED;
            } else {
            PG8_LDB(B0, 0, 0); PG8_SCHED; PG8_LDA(At, 0, 0); PG8_STAGE(PG8_SA(1, 1), a1 + hstep, voffA);
            PG8_WAIT_L(8); PG8_BAR; PG8_WAIT_L(0); PG8_MMA(0, 0, At, B0); PG8_BAR; PG8_SCHED;
            PG8_LDB(B1, 0, 1); PG8_STAGE(PG8_SB(0, 0), b2, voffB);
            PG8_BAR; PG8_WAIT_L(0); PG8_MMA(0, 1, At, B1); PG8_BAR;
            PG8_LDA(At, 0, 1); PG8_STAGE(PG8_SA(0, 0), a2, voffA);
            PG8_BAR; PG8_WAIT_L(0); PG8_MMA(1, 0, At, B0); PG8_BAR; PG8_SCHED;
            PG8_STAGE(PG8_SB(0, 1), b2 + hstep, voffB);
            PG8_WAIT_V(6); PG8_BAR; PG8_MMA(1, 1, At, B1); PG8_BAR;
            PG8_LDB(B0, 1, 0); PG8_SCHED; PG8_LDA(At, 1, 0); PG8_STAGE(PG8_SA(0, 1), a2 + hstep, voffA);
            PG8_WAIT_L(8); PG8_BAR; PG8_WAIT_L(0); PG8_MMA(0, 0, At, B0); PG8_BAR; PG8_SCHED;
            PG8_LDB(B1, 1, 1); PG8_STAGE(PG8_SB(1, 0), b3, voffB);
            PG8_BAR; PG8_WAIT_L(0); PG8_MMA(0, 1, At, B1); PG8_BAR;
            PG8_LDA(At, 1, 1); PG8_STAGE(PG8_SA(1, 0), a3, voffA);
            PG8_BAR; PG8_WAIT_L(0); PG8_MMA(1, 0, At, B0); PG8_BAR; PG8_SCHED;
            PG8_STAGE(PG8_SB(1, 1), b3 + hstep, voffB);
            PG8_WAIT_V(6); PG8_BAR; PG8_MMA(1, 1, At, B1); PG8_BAR;
            }
        }
        if constexpr (ALIGN_EPI) { if (wr == 0) PG8_BAR; }
        if constexpr (Epi::LANE_T == 3) { E.run(acc, cur, wr, wc, lane); S.done(cur); }
        else if constexpr (Epi::LANE_T == 2) {
            const bool hi_ = (lane & 8) != 0; const int rr_ = lane >> 3, c_ = lane & 7; const int pa = (rr_ + 8 * (c_ >> 2) + 16 * (c_ & 3)) << 2;
#pragma unroll
            for (int a = 0; a < 2; ++a)
#pragma unroll
                for (int b = 0; b < 2; ++b)
#pragma unroll
                    for (int m = 0; m < 4; ++m)
#pragma unroll
                        for (int e = 0; e < 4; ++e) { const float a0 = acc[a][b][m][0][e], a1 = acc[a][b][m][1][e]; const float snd = hi_ ? a0 : a1;
                            const float rcv = __int_as_float(__builtin_amdgcn_update_dpp(0, __float_as_int(snd), 0x128, 0xf, 0xf, false));
                            const float d0 = hi_ ? rcv : a0, d1 = hi_ ? a1 : rcv;
                            acc[a][b][m][0][e] = __int_as_float(__builtin_amdgcn_ds_bpermute(pa, __float_as_int(d0))); acc[a][b][m][1][e] = __int_as_float(__builtin_amdgcn_ds_bpermute(pa, __float_as_int(d1))); }
            E(acc, cur, wr, wc, rr_, c_); S.done(cur);
        } else if constexpr (Epi::LANE_T == 1) {
            const int pa = ((lane >> 2) + 16 * (lane & 3)) << 2;
#pragma unroll
            for (int a = 0; a < 2; ++a)
#pragma unroll
                for (int b = 0; b < 2; ++b)
#pragma unroll
                    for (int m = 0; m < 4; ++m)
#pragma unroll
                        for (int n = 0; n < 2; ++n)
#pragma unroll
                            for (int e = 0; e < 4; ++e) { const float t_ = acc[a][b][m][n][e]; acc[a][b][m][n][e] = __int_as_float(__builtin_amdgcn_ds_bpermute(pa, __float_as_int(t_))); }
            E(acc, cur, wr, wc, lane >> 2, lane & 3); S.done(cur);
        } else if constexpr (!Epi::AFTER_DRAIN) { E(acc, cur, wr, wc, fr, fq); S.done(cur); }
        if (!has_next) break;
#pragma unroll
        for (int a = 0; a < 2; ++a)
#pragma unroll
            for (int b = 0; b < 2; ++b)
#pragma unroll
                for (int m = 0; m < 4; ++m)
#pragma unroll
                    for (int n = 0; n < 2; ++n) acc[a][b][m][n] = (f32x4){0.f, 0.f, 0.f, 0.f};
        cur = nxt; cA = nA; cB = nB; ++ui;
        if constexpr (ALIGN_EPI) { if (wr == 1) PG8_BAR; }
    }
    PG8_WAIT_V(0);
    if constexpr (!ALIGN_EPI) { if (wr == 0) PG8_BAR; }
    PG8_BAR;
    if constexpr (Epi::AFTER_DRAIN) { E.fused(acc, cur, wr, wc, fr, fq, lds, wid, lane); S.done(cur); }
#undef PG8_SA
#undef PG8_SB
#undef PG8_STAGE
#undef PG8_LDA
#undef PG8_LDB
#undef PG8_MMA
#undef PG8_WAIT_V
#undef PG8_WAIT_L
#undef PG8_BAR
#undef PG8_SCHED
}
}
#define EPI4 EpiResid7
#define EPI6 EpiOut6L
#define EPI1 EpiProj4
#define EPI1_ARG a.pos

constexpr int NWAVES = 8, NTHR = NWAVES * 64;
constexpr int BATCH = 16, SEQ = 4096, DM = 1024, M = BATCH * SEQ;
constexpr int RH = 8, RD = 64, RW = 512, RCH = 128;
constexpr int MH = 8, QRANK = 256, KVRANK = 128, NOPE = 64, ROPE = 32, QKD = 96, VD = 64, MW = 512;
constexpr int NIN = 2464, NINP = 2560, DFF = 2816, NGU = 2 * DFF;
constexpr int C_Q = 0, C_K = 512, C_V = 1024, C_G = 1536, C_CQ = 2048, C_CKV = 2304, C_KR = 2432;
constexpr float EPS = 1e-6f, GN_EPS = 1e-5f;
constexpr int BH = BATCH * MH;
constexpr float ATT_C2 = 0.10206207261596577f * 1.4426950408889634f;

constexpr size_t MiB = 1u << 20;
constexpr size_t WS_LG = 131072;
constexpr size_t WS_ROT = 1 * MiB;
constexpr size_t WS_SSQ = 17 * MiB;
constexpr size_t WS_RSTD = 21 * MiB;
constexpr size_t WS_WIN = 22 * MiB;
constexpr size_t WS_WUQ = 27 * MiB;
constexpr size_t WS_WUKV = 28 * MiB;
constexpr size_t WS_WO = 29 * MiB;
constexpr size_t WS_WGU = 31 * MiB;
constexpr size_t WS_WDN = 42 * MiB;
constexpr size_t WS_XN = 48 * MiB;
constexpr size_t WS_MIX = 176 * MiB;
constexpr size_t WS_PROJ = 304 * MiB;
constexpr size_t WS_QM = 624 * MiB;
constexpr size_t WS_KM = 720 * MiB;
constexpr size_t WS_VM = 816 * MiB;
constexpr size_t WS_ACT = 304 * MiB;
constexpr size_t WS_RB = 880 * MiB;
constexpr size_t WS_END = 912 * MiB;
static_assert(WS_ACT + (size_t)M * DFF * 2 <= WS_KM, "act overlay");

constexpr int LDS_BYTES = 163840;

#define LAS __attribute__((address_space(3)))
typedef unsigned short bf16;
typedef unsigned v4u __attribute__((ext_vector_type(4)));
typedef unsigned v2u __attribute__((ext_vector_type(2)));
typedef float f32x4 __attribute__((ext_vector_type(4)));
#define LDS_WAIT() asm volatile("s_waitcnt lgkmcnt(0)" ::: "memory")
__device__ __forceinline__ unsigned f2bf(float f) { unsigned u = __builtin_bit_cast(unsigned, f); return (u + 0x7fffu + ((u >> 16) & 1u)) >> 16; }
__device__ __forceinline__ unsigned pk2(float lo, float hi) { return f2bf(lo) | (f2bf(hi) << 16); }
__device__ __forceinline__ float bf2f(unsigned short b) { return __builtin_bit_cast(float, (unsigned)b << 16); }
__device__ __forceinline__ float bflo(unsigned w) { return __builtin_bit_cast(float, w << 16); }
__device__ __forceinline__ float bfhi(unsigned w) { return __builtin_bit_cast(float, w & 0xffff0000u); }
__device__ __forceinline__ float wave_sum(float v) {
#pragma unroll
    for (int o = 1; o < 64; o <<= 1) v += __shfl_xor(v, o);
    return v;
}

struct Args { const float* x; const int* pos; const float* g1; const float* w_in; const float* lf; const float* lb; const float* qag; const float* w_uq; const float* kvag; const float* w_ukv;
              const float* qng; const float* kng; const float* w_o; const float* g2; const float* w_gate; const float* w_up; const float* w_down; float* out; unsigned char* ws; };

__device__ __forceinline__ void tr_item(const float* W, int N, const float* ks, bf16* WT, int ldt, int k0, int n0, int orow0, LAS float* scr, int lane) {
    { f32x4 v[8];
#pragma unroll
      for (int i = 0; i < 8; ++i) v[i] = *(const f32x4*)(W + (size_t)(k0 + 8 * i + (lane >> 3)) * N + n0 + 4 * (lane & 7));
#pragma unroll
      for (int i = 0; i < 8; ++i) { const int kk = 8 * i + (lane >> 3); const float s_ = ks ? ks[k0 + kk] : 1.0f;
#pragma unroll
          for (int e = 0; e < 4; ++e) scr[kk * 33 + 4 * (lane & 7) + e] = v[i][e] * s_; } }
    LDS_WAIT(); asm volatile("" ::: "memory");
    const int c = lane & 7;
#pragma unroll
    for (int j = 0; j < 4; ++j) { const int n = (lane >> 3) + 8 * j; const LAS float* s = scr + (8 * c) * 33 + n;
        v4u o; o.x = pk2(s[0 * 33], s[1 * 33]); o.y = pk2(s[2 * 33], s[3 * 33]); o.z = pk2(s[4 * 33], s[5 * 33]); o.w = pk2(s[6 * 33], s[7 * 33]);
        *(v4u*)(WT + (size_t)(orow0 + n) * ldt + k0 + 8 * c) = o; }
    LDS_WAIT(); asm volatile("" ::: "memory");
}
__device__ __forceinline__ void p0_prologue(const Args& a, LAS unsigned char* lds, int gw, int NGW, int wave, int lane) {
    unsigned char* ws = a.ws;
    LAS float* scr = (LAS float*)(lds + wave * 16384);
    bf16* Wt_in = (bf16*)(ws + WS_WIN); bf16* Wt_uq = (bf16*)(ws + WS_WUQ); bf16* Wt_ukv = (bf16*)(ws + WS_WUKV); bf16* Wt_o = (bf16*)(ws + WS_WO); bf16* Wt_gu = (bf16*)(ws + WS_WGU); bf16* Wt_dn = (bf16*)(ws + WS_WDN);
    constexpr int I_IN = (DM / 64) * (NIN / 32), I_UQ = (QRANK / 64) * (MH * QKD / 32), I_UKV = (KVRANK / 64) * (MH * 128 / 32), I_O = (DM / 64) * (DM / 32), I_G = (DM / 64) * (DFF / 32), I_D = (DFF / 64) * (DM / 32);
    constexpr int NITEMS = I_IN + I_UQ + I_UKV + I_O + 2 * I_G + I_D;
    for (int it = gw; it < NITEMS; it += NGW) {
        int r = it;
        if (r < I_IN) { const int nb = NIN / 32, kb = r / nb, n0 = 32 * (r % nb); tr_item(a.w_in, NIN, nullptr, Wt_in, DM, 64 * kb, n0, n0 < 1024 ? (n0 & ~255) + ((n0 >> 5) & 1) * 128 + ((n0 >> 6) & 3) * 32 : n0, scr, lane); continue; } r -= I_IN;
        if (r < I_UQ) { const int nb = MH * QKD / 32, kb = r / nb, n0 = 32 * (r % nb); tr_item(a.w_uq, MH * QKD, a.qag, Wt_uq, QRANK, 64 * kb, n0, n0, scr, lane); continue; } r -= I_UQ;
        if (r < I_UKV) { const int nb = MH * 128 / 32, kb = r / nb, n0 = 32 * (r % nb); tr_item(a.w_ukv, MH * 128, a.kvag, Wt_ukv, KVRANK, 64 * kb, n0, n0, scr, lane); continue; } r -= I_UKV;
        if (r < I_O) { const int nb = DM / 32, kb = r / nb, n0 = 32 * (r % nb); tr_item(a.w_o, DM, nullptr, Wt_o, DM, 64 * kb, n0, n0, scr, lane); continue; } r -= I_O;
        if (r < I_G) { const int nb = DFF / 32, kb = r / nb, n0 = 32 * (r % nb); tr_item(a.w_gate, DFF, a.g2, Wt_gu, DM, 64 * kb, n0, (n0 / 128) * 256 + (n0 % 128), scr, lane); continue; } r -= I_G;
        if (r < I_G) { const int nb = DFF / 32, kb = r / nb, n0 = 32 * (r % nb); tr_item(a.w_up, DFF, a.g2, Wt_gu, DM, 64 * kb, n0, (n0 / 128) * 256 + 128 + (n0 % 128), scr, lane); continue; } r -= I_G;
        { const int nb = DM / 32, kb = r / nb, n0 = 32 * (r % nb); tr_item(a.w_down, DM, nullptr, Wt_dn, DFF, 64 * kb, n0, n0, scr, lane); }
    }
    if (gw == 0 && lane < 2 * RH) ((float*)(ws + WS_LG))[lane] = (float)(-log1p(exp(-(double)(lane < RH ? a.lf[lane] : a.lb[lane - RH]))) * 1.4426950408889634);
    { const int gt = gw * 64 + lane, NGT = NGW * 64; v4u z = {0u, 0u, 0u, 0u}; v4u* p = (v4u*)(Wt_in + (size_t)NIN * DM);
      for (int i = gt; i < (NINP - NIN) * DM / 8; i += NGT) p[i] = z; }
    { bf16* XN = (bf16*)(ws + WS_XN); f32x4 gv[4];
#pragma unroll
      for (int j = 0; j < 4; ++j) gv[j] = ((const f32x4*)a.g1)[lane + 64 * j];
      for (int m = gw; m < M; m += NGW) { const f32x4* xr = (const f32x4*)(a.x + (size_t)m * DM) + lane; f32x4 v[4]; float s = 0.f;
#pragma unroll
          for (int j = 0; j < 4; ++j) { v[j] = xr[64 * j]; s += (v[j].x * v[j].x + v[j].y * v[j].y) + (v[j].z * v[j].z + v[j].w * v[j].w); }
          const float rstd = 1.0f / sqrtf(wave_sum(s) * (1.f / DM) + EPS);
          unsigned long long* o8 = (unsigned long long*)(XN + (size_t)m * DM) + lane;
#pragma unroll
          for (int j = 0; j < 4; ++j) { const f32x4 y = v[j] * rstd * gv[j]; o8[64 * j] = (unsigned long long)pk2(y.x, y.y) | ((unsigned long long)pk2(y.z, y.w) << 32); } } }
}

namespace p2f {
using bf16x8 = __attribute__((ext_vector_type(8))) short;
using f32x16 = __attribute__((ext_vector_type(16))) float;
constexpr int WQ_BYTES = QKD * QRANK * 2, WKV_BYTES = 128 * KVRANK * 2;
constexpr int QST = 208, VST = 144;
constexpr int A_STAGE = 2 * WQ_BYTES, A_STAGE_W = 32 * QST;
constexpr int B_STAGE = 2 * WKV_BYTES, B_STAGE_W = 32 * QST + 32 * VST;
constexpr int L_G = 156672;
static_assert(A_STAGE + 8 * A_STAGE_W <= L_G && B_STAGE + 8 * B_STAGE_W <= L_G && L_G + 768 <= LDS_BYTES - 64, "P2 LDS map");
__device__ __forceinline__ int crow(int r, int hi) { return (r & 3) + 8 * (r >> 2) + 4 * hi; }
__device__ __forceinline__ float swap_add(float v) { auto rr = __builtin_amdgcn_permlane32_swap(__float_as_uint(v), __float_as_uint(v), false, false); return __uint_as_float(rr[0]) + __uint_as_float(rr[1]); }
__device__ __forceinline__ float sumsq8(bf16x8 v) { float s = 0.f;
#pragma unroll
  for (int j = 0; j < 8; ++j) { const float f = bf2f((unsigned short)v[j]); s += f * f; } return s; }
typedef float f32x2_t __attribute__((ext_vector_type(2))); typedef __bf16 bf16x2_t __attribute__((ext_vector_type(2)));
__device__ __forceinline__ unsigned cvt2(float lo, float hi) { f32x2_t v = {lo, hi}; bf16x2_t b = __builtin_convertvector(v, bf16x2_t); return __builtin_bit_cast(unsigned, b); }
__device__ __forceinline__ v2u pk4(float a, float b, float c, float d) { v2u w; w.x = cvt2(a, b); w.y = cvt2(c, d); return w; }
__device__ __forceinline__ void glds16(const void* gsrc, unsigned lds_dst) { unsigned keep;
  asm volatile("s_mov_b32 %0, m0\n\ts_mov_b32 m0, %2\n\ts_nop 0\n\tglobal_load_lds_dwordx4 %1, off\n\ts_mov_b32 m0, %0" : "=&s"(keep) : "v"(gsrc), "s"(lds_dst) : "memory"); }
#define P2_WAIT_BAR() asm volatile("s_waitcnt vmcnt(0) lgkmcnt(0)\n\ts_barrier" ::: "memory")
#define P2_WAIT_BAR_N(N) asm volatile("s_waitcnt vmcnt(" #N ") lgkmcnt(0)\n\ts_barrier" ::: "memory")
__device__ __forceinline__ void run(const Args& a, unsigned char* lds, int bid, int G) {
  unsigned char* ws = a.ws;
  const bf16* PROJ = (const bf16*)(ws + WS_PROJ); const bf16* Wt_uq = (const bf16*)(ws + WS_WUQ); const bf16* Wt_ukv = (const bf16*)(ws + WS_WUKV);
  bf16* QM = (bf16*)(ws + WS_QM); bf16* KM = (bf16*)(ws + WS_KM); bf16* VM = (bf16*)(ws + WS_VM);
  int tid_ = threadIdx.x; asm volatile("" : "+v"(tid_));
  const int tid = tid_, lane = tid & 63, r32 = lane & 31, hi = lane >> 5; const int wid = __builtin_amdgcn_readfirstlane(tid >> 6);
  const unsigned lds0 = (unsigned)(uintptr_t)lds;
  float* gl = (float*)(lds + L_G);
  __syncthreads();
  if (tid < 96) gl[tid] = a.qng[tid]; else if (tid < 192) gl[tid] = a.kng[tid - 96];
  for (int tb = bid; tb < M / 256; tb += G) {
    const int m0 = tb * 256 + wid * 32, m = m0 + r32, b = m / SEQ, s = m % SEQ, s0 = m0 % SEQ;
    const bf16* prow = PROJ + (size_t)m * NINP;
    const float posf = (float)a.pos[m];
    float rotx[8];
#pragma unroll
    for (int r = 0; r < 8; ++r) { const float ang_ = posf * __builtin_amdgcn_exp2f(-(float)crow(r, hi) * (13.287712379549449f / 16.0f)); const float rev_ = ang_ * 0.15915494f;
      rotx[r] = __builtin_amdgcn_fractf(rev_) + (__builtin_fmaf(ang_, 0.15915494f, -rev_) + ang_ * 6.4206383e-9f); }
    {
#define P2_DMA_Q(h, buf) do { int ll_ = lane; asm volatile("" : "+v"(ll_)); const int rl_ = 2 * wid + (ll_ >> 5), p_ = ll_ & 31, c_ = (p_ & 16) | ((p_ & 15) ^ (rl_ & 15)); const bf16* ls_ = Wt_uq + rl_ * QRANK + c_ * 8; \
        _Pragma("unroll") for (int i_ = 0; i_ < 6; ++i_) glds16(ls_ + (size_t)((h) * QKD + 16 * i_) * QRANK, (unsigned)__builtin_amdgcn_readfirstlane(lds0 + (buf) * WQ_BYTES + (wid + 8 * i_) * 1024)); } while (0)
      P2_WAIT_BAR();
      P2_DMA_Q(0, 0);
      bf16x8 bq[16];
#pragma unroll
      for (int k = 0; k < 16; ++k) bq[k] = *(const bf16x8*)(prow + C_CQ + 16 * k + 8 * hi);
      float sq = 0.f;
#pragma unroll
      for (int k = 0; k < 16; ++k) sq += sumsq8(bq[k]);
      sq = swap_add(sq);
      const float rq = __builtin_amdgcn_rsqf(sq * (1.f / QRANK) + EPS);
      unsigned char* stg = lds + A_STAGE + wid * A_STAGE_W;
      for (int h = 0; h < MH; ++h) {
        if (h == 0) { P2_WAIT_BAR(); } else { P2_WAIT_BAR_N(6); }
        if (h + 1 < MH) P2_DMA_Q(h + 1, (h + 1) & 1);
        const unsigned char* wb = lds + (h & 1) * WQ_BYTES;
        f32x16 acc[3] = {};
#pragma unroll
        for (int k = 0; k < 16; ++k)
#pragma unroll
          for (int t = 0; t < 3; ++t) { const int row = 32 * t + r32, c = 2 * k + hi; const bf16x8 af = *(const bf16x8*)(wb + row * 512 + (((c & 16) | ((c & 15) ^ (row & 15))) << 4));
            acc[t] = __builtin_amdgcn_mfma_f32_32x32x16_bf16(af, bq[k], acc[t], 0, 0, 0); }
        float ss = 0.f;
#pragma unroll
        for (int t = 0; t < 3; ++t)
#pragma unroll
          for (int r = 0; r < 16; ++r) ss += acc[t][r] * acc[t][r];
        ss = swap_add(ss);
        const float rr = ATT_C2 * rq * __builtin_amdgcn_rsqf(rq * rq * ss * (1.f / QKD) + EPS);
        unsigned char* srow = stg + r32 * QST;
#pragma unroll
        for (int t = 0; t < 2; ++t)
#pragma unroll
          for (int q4 = 0; q4 < 4; ++q4) { const int f0 = 32 * t + 8 * q4 + 4 * hi; const f32x4 g = *(const f32x4*)(gl + f0);
            *(v2u*)(srow + f0 * 2) = pk4(acc[t][4 * q4] * rr * g[0], acc[t][4 * q4 + 1] * rr * g[1], acc[t][4 * q4 + 2] * rr * g[2], acc[t][4 * q4 + 3] * rr * g[3]); }
        float y[16];
#pragma unroll
        for (int q4 = 0; q4 < 4; ++q4) { const f32x4 g = *(const f32x4*)(gl + 64 + 8 * q4 + 4 * hi);
#pragma unroll
          for (int e = 0; e < 4; ++e) y[4 * q4 + e] = acc[2][4 * q4 + e] * rr * g[e]; }
        float lo[8], up[8];
        {
#pragma unroll
        for (int r = 0; r < 8; ++r) { float x_ = rotx[r]; asm volatile("" : "+v"(x_));
          const float cs_ = __builtin_amdgcn_cosf(x_), sn_ = __builtin_amdgcn_sinf(x_);
          lo[r] = y[r] * cs_ - y[r + 8] * sn_; up[r] = y[r + 8] * cs_ + y[r] * sn_; } }
        *(v2u*)(srow + (64 + 4 * hi) * 2) = pk4(lo[0], lo[1], lo[2], lo[3]); *(v2u*)(srow + (72 + 4 * hi) * 2) = pk4(lo[4], lo[5], lo[6], lo[7]);
        *(v2u*)(srow + (80 + 4 * hi) * 2) = pk4(up[0], up[1], up[2], up[3]); *(v2u*)(srow + (88 + 4 * hi) * 2) = pk4(up[4], up[5], up[6], up[7]);
        bf16* qp = QM + ((size_t)(b * MH + h) * SEQ + s0) * QKD;
#pragma unroll
        for (int i = 0; i < 6; ++i) { int ll = lane; asm volatile("" : "+v"(ll)); const int idx = i * 64 + ll, row = (idx * 5462) >> 16, ch = idx - 12 * row; __builtin_nontemporal_store(*(const v4u*)(stg + row * QST + ch * 16), (v4u*)(qp + idx * 8)); }
      }
#undef P2_DMA_Q
    }
    {
#define P2_DMA_KV(h, buf) do { int ll_ = lane; asm volatile("" : "+v"(ll_)); const int rl_ = 4 * wid + (ll_ >> 4), c_ = (ll_ & 15) ^ (rl_ & 15); const bf16* ls_ = Wt_ukv + rl_ * KVRANK + c_ * 8; \
        _Pragma("unroll") for (int i_ = 0; i_ < 4; ++i_) glds16(ls_ + (size_t)((h) * 128 + 32 * i_) * KVRANK, (unsigned)__builtin_amdgcn_readfirstlane(lds0 + (buf) * WKV_BYTES + (wid + 8 * i_) * 1024)); } while (0)
      P2_WAIT_BAR_N(6);
      P2_DMA_KV(0, 0);
      bf16x8 bkv[8]; float krf[16];
#pragma unroll
      for (int k = 0; k < 8; ++k) bkv[k] = *(const bf16x8*)(prow + C_CKV + 16 * k + 8 * hi);
#pragma unroll
      for (int q4 = 0; q4 < 4; ++q4) { const v2u w = *(const v2u*)(prow + C_KR + 8 * q4 + 4 * hi); krf[4 * q4] = bflo(w.x); krf[4 * q4 + 1] = bfhi(w.x); krf[4 * q4 + 2] = bflo(w.y); krf[4 * q4 + 3] = bfhi(w.y); }
      float skv = 0.f, skr = 0.f;
#pragma unroll
      for (int k = 0; k < 8; ++k) skv += sumsq8(bkv[k]);
#pragma unroll
      for (int r = 0; r < 16; ++r) skr += krf[r] * krf[r];
      skv = swap_add(skv); skr = swap_add(skr);
      const float rkv = __builtin_amdgcn_rsqf(skv * (1.f / KVRANK) + EPS);
      unsigned char* stg = lds + B_STAGE + wid * B_STAGE_W; unsigned char* stv = stg + 32 * QST;
      for (int h = 0; h < MH; ++h) {
        if (h == 0) { P2_WAIT_BAR(); } else { P2_WAIT_BAR_N(10); }
        if (h + 1 < MH) P2_DMA_KV(h + 1, (h + 1) & 1);
        const unsigned char* wb = lds + (h & 1) * WKV_BYTES;
        f32x16 acc[4] = {};
#pragma unroll
        for (int k = 0; k < 8; ++k)
#pragma unroll
          for (int t = 0; t < 4; ++t) { const int row = 32 * t + r32, c = 2 * k + hi; const bf16x8 af = *(const bf16x8*)(wb + row * 256 + ((c ^ (row & 15)) << 4));
            acc[t] = __builtin_amdgcn_mfma_f32_32x32x16_bf16(af, bkv[k], acc[t], 0, 0, 0); }
        float ss = 0.f;
#pragma unroll
        for (int t = 0; t < 2; ++t)
#pragma unroll
          for (int r = 0; r < 16; ++r) ss += acc[t][r] * acc[t][r];
        ss = swap_add(ss);
        const float rk = __builtin_amdgcn_rsqf((rkv * rkv * ss + skr) * (1.f / QKD) + EPS), rr = rkv * rk;
        unsigned char* srow = stg + r32 * QST; unsigned char* vrow = stv + r32 * VST;
#pragma unroll
        for (int t = 0; t < 2; ++t)
#pragma unroll
          for (int q4 = 0; q4 < 4; ++q4) { const int f0 = 32 * t + 8 * q4 + 4 * hi; const f32x4 g = *(const f32x4*)(gl + 96 + f0);
            *(v2u*)(srow + f0 * 2) = pk4(acc[t][4 * q4] * rr * g[0], acc[t][4 * q4 + 1] * rr * g[1], acc[t][4 * q4 + 2] * rr * g[2], acc[t][4 * q4 + 3] * rr * g[3]);
            *(v2u*)(vrow + f0 * 2) = pk4(acc[2 + t][4 * q4] * rkv, acc[2 + t][4 * q4 + 1] * rkv, acc[2 + t][4 * q4 + 2] * rkv, acc[2 + t][4 * q4 + 3] * rkv); }
        float y[16];
#pragma unroll
        for (int q4 = 0; q4 < 4; ++q4) { const f32x4 g = *(const f32x4*)(gl + 96 + 64 + 8 * q4 + 4 * hi);
#pragma unroll
          for (int e = 0; e < 4; ++e) y[4 * q4 + e] = krf[4 * q4 + e] * rk * g[e]; }
        float lo[8], up[8];
        {
#pragma unroll
        for (int r = 0; r < 8; ++r) { float x_ = rotx[r]; asm volatile("" : "+v"(x_));
          const float cs_ = __builtin_amdgcn_cosf(x_), sn_ = __builtin_amdgcn_sinf(x_);
          lo[r] = y[r] * cs_ - y[r + 8] * sn_; up[r] = y[r + 8] * cs_ + y[r] * sn_; } }
        *(v2u*)(srow + (64 + 4 * hi) * 2) = pk4(lo[0], lo[1], lo[2], lo[3]); *(v2u*)(srow + (72 + 4 * hi) * 2) = pk4(lo[4], lo[5], lo[6], lo[7]);
        *(v2u*)(srow + (80 + 4 * hi) * 2) = pk4(up[0], up[1], up[2], up[3]); *(v2u*)(srow + (88 + 4 * hi) * 2) = pk4(up[4], up[5], up[6], up[7]);
        bf16* kp = KM + ((size_t)(b * MH + h) * SEQ + s0) * QKD; bf16* vp = VM + ((size_t)(b * MH + h) * SEQ + s0) * VD;
#pragma unroll
        for (int i = 0; i < 6; ++i) { int ll = lane; asm volatile("" : "+v"(ll)); const int idx = i * 64 + ll, row = (idx * 5462) >> 16, ch = idx - 12 * row; __builtin_nontemporal_store(*(const v4u*)(stg + row * QST + ch * 16), (v4u*)(kp + idx * 8)); }
#pragma unroll
        for (int i = 0; i < 4; ++i) { int ll = lane; asm volatile("" : "+v"(ll)); const int idx = i * 64 + ll, row = idx >> 3, ch = idx & 7; __builtin_nontemporal_store(*(const v4u*)(stv + row * VST + ch * 16), (v4u*)(vp + idx * 8)); }
      }
#undef P2_DMA_KV
    }
  }
  P2_WAIT_BAR();
}
#undef P2_WAIT_BAR
#undef P2_WAIT_BAR_N
}

namespace att {
using bf16x8 = __attribute__((ext_vector_type(8))) short;
using s16x4  = __attribute__((ext_vector_type(4))) short;
using f32x16 = __attribute__((ext_vector_type(16))) float;
using u32x4  = __attribute__((ext_vector_type(4))) unsigned;
constexpr int NW = 8, QBLK = 32, KVBLK = 64, DQK = 96, DV = 64;
constexpr float SCALE = 0.10206207261596577f;
constexpr float THR = 8.f;
constexpr int KROW = 208;
constexpr int SHM_K = KVBLK * KROW, SHM_V = KVBLK * DV * 2;
constexpr int L_V = 0, L_K = 2 * SHM_V, L_WS = L_K + 2 * SHM_K, L_OST = L_WS + NW * 64 * 4, L_BYTES = L_OST + NW * 4096;
#define ATT_SBAR() __builtin_amdgcn_sched_barrier(0)
__device__ __forceinline__ int crow(int r, int hi) { return (r & 3) + 8 * (r >> 2) + 4 * hi; }
__device__ __forceinline__ unsigned cvtpk(float lo, float hi) { unsigned r; asm volatile("v_cvt_pk_bf16_f32 %0, %1, %2" : "=v"(r) : "v"(lo), "v"(hi)); return r; }
__device__ __forceinline__ void partialSM(f32x16& p0, f32x16& p1, float& m_reg, float& mn, float& alpha) {
  constexpr float C = 1.0f;
  float pmax = p0[0];
#pragma unroll
  for (int r = 1; r < 16; ++r) pmax = fmaxf(pmax, p0[r]);
#pragma unroll
  for (int r = 0; r < 16; ++r) pmax = fmaxf(pmax, p1[r]);
  { auto rr = __builtin_amdgcn_permlane32_swap(__float_as_uint(pmax), __float_as_uint(pmax), false, false);
    pmax = fmaxf(__uint_as_float(rr[0]), __uint_as_float(rr[1])); }
  if (__builtin_expect(__all(pmax - m_reg <= THR * 1.4426950408889634f), 1)) { mn = m_reg; alpha = 1.f; }
  else { mn = fmaxf(m_reg, pmax); alpha = __builtin_amdgcn_exp2f((m_reg - mn) * C); m_reg = mn; }
  const float mnC = -mn * C;
#pragma unroll
  for (int r = 0; r < 16; ++r) p0[r] = fmaf(p0[r], C, mnC);
#pragma unroll
  for (int r = 0; r < 16; ++r) p1[r] = fmaf(p1[r], C, mnC);
#pragma unroll
  for (int r = 0; r < 16; ++r) p0[r] = __builtin_amdgcn_exp2f(p0[r]);
}
__device__ __forceinline__ void finishSM(f32x16& p0, f32x16& p1, float alpha, float& l_reg, bf16x8& pa0, bf16x8& pa1, bf16x8& pa2, bf16x8& pa3) {
#pragma unroll
  for (int r = 0; r < 16; ++r) p1[r] = __builtin_amdgcn_exp2f(p1[r]);
  float ps = 0;
#pragma unroll
  for (int r = 0; r < 16; ++r) ps += p0[r];
#pragma unroll
  for (int r = 0; r < 16; ++r) ps += p1[r];
  { auto rr = __builtin_amdgcn_permlane32_swap(__float_as_uint(ps), __float_as_uint(ps), false, false);
    ps = __uint_as_float(rr[0]) + __uint_as_float(rr[1]); }
  l_reg = l_reg * alpha + ps;
#define ATT_PK4(P, BASE, OUT) do { unsigned a0 = cvtpk(P[BASE + 0], P[BASE + 1]), a1 = cvtpk(P[BASE + 2], P[BASE + 3]);   \
    unsigned b0 = cvtpk(P[BASE + 4], P[BASE + 5]), b1 = cvtpk(P[BASE + 6], P[BASE + 7]);                              \
    auto r0 = __builtin_amdgcn_permlane32_swap(a0, b0, false, false); auto r1 = __builtin_amdgcn_permlane32_swap(a1, b1, false, false); \
    u32x4 w = {r0[0], r1[0], r0[1], r1[1]}; OUT = __builtin_bit_cast(bf16x8, w); } while (0)
  ATT_PK4(p0, 0, pa0); ATT_PK4(p0, 8, pa1); ATT_PK4(p1, 0, pa2); ATT_PK4(p1, 8, pa3);
#undef ATT_PK4
}
__device__ __forceinline__ void qkt(f32x16& p0, f32x16& p1, const char* Ks, const bf16x8* qr, int r32, int hi) {
  p0 = f32x16{}; p1 = f32x16{};
#pragma unroll
  for (int d0 = 0; d0 < 6; ++d0) { const int cb = (d0 * 16 + hi * 8) * 2;
    const bf16x8 b0 = *reinterpret_cast<const bf16x8*>(Ks + r32 * KROW + cb);
    const bf16x8 b1 = *reinterpret_cast<const bf16x8*>(Ks + (32 + r32) * KROW + cb);
    p0 = __builtin_amdgcn_mfma_f32_32x32x16_bf16(b0, qr[d0], p0, 0, 0, 0);
    p1 = __builtin_amdgcn_mfma_f32_32x32x16_bf16(b1, qr[d0], p1, 0, 0, 0); }
}
__device__ __forceinline__ int v_st(int k, int c) { const int kk = (k & ~0xC) | ((k & 4) << 1) | ((k & 8) >> 1); return ((kk >> 3) * 2 + (c >> 5)) * 512 + ((kk & 7) * 32 + (c & 31)) * 2; }
__device__ __forceinline__ int v_rd_base(int lane) { return ((lane & 3) << 3) | (((lane >> 2) & 3) << 6) | (((lane >> 4) & 1) << 5) | (((lane >> 5) & 1) << 8); }
constexpr int v_rd_off(int d0, int ks, int half) { return d0 * 512 + ks * 2048 + half * 1024; }
template <int OFF> __device__ __forceinline__ s16x4 tr_read(int vb) {
  s16x4 r; asm volatile("ds_read_b64_tr_b16 %0, %1 offset:%2" : "=&v"(r) : "v"(vb), "i"(OFF) : "memory"); return r;
}
template <int D0> __device__ __forceinline__ void pv_one(f32x16& od, int vb, bf16x8 pa0, bf16x8 pa1, bf16x8 pa2, bf16x8 pa3) {
  const s16x4 l0 = tr_read<v_rd_off(D0, 0, 0)>(vb), h0 = tr_read<v_rd_off(D0, 0, 1)>(vb), l1 = tr_read<v_rd_off(D0, 1, 0)>(vb), h1 = tr_read<v_rd_off(D0, 1, 1)>(vb);
  const s16x4 l2 = tr_read<v_rd_off(D0, 2, 0)>(vb), h2 = tr_read<v_rd_off(D0, 2, 1)>(vb), l3 = tr_read<v_rd_off(D0, 3, 0)>(vb), h3 = tr_read<v_rd_off(D0, 3, 1)>(vb);
  asm volatile("s_waitcnt lgkmcnt(0)" ::: "memory"); ATT_SBAR();
#define ATT_PK(L, H) (bf16x8){L[0], L[1], L[2], L[3], H[0], H[1], H[2], H[3]}
  od = __builtin_amdgcn_mfma_f32_32x32x16_bf16(pa0, ATT_PK(l0, h0), od, 0, 0, 0);
  od = __builtin_amdgcn_mfma_f32_32x32x16_bf16(pa1, ATT_PK(l1, h1), od, 0, 0, 0);
  od = __builtin_amdgcn_mfma_f32_32x32x16_bf16(pa2, ATT_PK(l2, h2), od, 0, 0, 0);
  od = __builtin_amdgcn_mfma_f32_32x32x16_bf16(pa3, ATT_PK(l3, h3), od, 0, 0, 0);
#undef ATT_PK
}
__device__ __forceinline__ void pv_d0(f32x16* o, int vb, bf16x8 pa0, bf16x8 pa1, bf16x8 pa2, bf16x8 pa3) {
  pv_one<0>(o[0], vb, pa0, pa1, pa2, pa3); pv_one<1>(o[1], vb, pa0, pa1, pa2, pa3);
}
__device__ __forceinline__ void attn_unit(const unsigned short* __restrict__ Qb, const unsigned short* __restrict__ Kh, const unsigned short* __restrict__ Vh, unsigned short* Ob, int ldo, int seq, char* lds) {
  int tid_ = threadIdx.x; asm volatile("" : "+v"(tid_));
  const int tid = tid_, wid = tid >> 6, lane = tid & 63, r32 = lane & 31, hi = lane >> 5;
  char* V_lds = lds + L_V; char* K_lds = lds + L_K;
  float* ws = (float*)(lds + L_WS) + wid * 64; float* li_l = ws; float* al_l = ws + 32;
  float m_reg = -1e30f, l_reg = 0; f32x16 o[2] = {}; bf16x8 qr[6];
  const unsigned short* Qw = Qb + (long)(wid * QBLK + r32) * DQK + hi * 8;
#pragma unroll
  for (int d0 = 0; d0 < 6; ++d0) qr[d0] = *reinterpret_cast<const bf16x8*>(Qw + d0 * 16);
  const int sr = tid >> 3, sc = (tid & 7) * 8, sr2 = tid >> 2, sc2 = 64 + (tid & 3) * 8; const bool two = tid < 256;
  const int vst = v_st(sr, sc), kst = sr * KROW + sc * 2, kst2 = sr2 * KROW + sc2 * 2;
  const int vb0 = (int)(uintptr_t)V_lds + v_rd_base(lane);
  struct { bf16x8 v, k, k2; } sg[2];
#define ATT_SLOAD(i, k0) do { sg[i].v = *reinterpret_cast<const bf16x8*>(&Vh[(long)((k0) + sr) * DV + sc]); sg[i].k = *reinterpret_cast<const bf16x8*>(&Kh[(long)((k0) + sr) * DQK + sc]); \
    if (two) sg[i].k2 = *reinterpret_cast<const bf16x8*>(&Kh[(long)((k0) + sr2) * DQK + sc2]); } while (0)
#define ATT_SWRITE(b, i) do { *(bf16x8*)(V_lds + (b) * SHM_V + vst) = sg[i].v; *(bf16x8*)(K_lds + (b) * SHM_K + kst) = sg[i].k; if (two) *(bf16x8*)(K_lds + (b) * SHM_K + kst2) = sg[i].k2; } while (0)
#define ATT_RESC(a) do { if (__any((a) < 1.f)) { if (hi == 0) al_l[r32] = (a); asm volatile("s_waitcnt lgkmcnt(0)" ::: "memory"); \
    _Pragma("unroll") for (int d = 0; d < 2; ++d) _Pragma("unroll") for (int r = 0; r < 16; ++r) o[d][r] *= al_l[crow(r, hi)]; } } while (0)
  f32x16 pA0, pA1, pB0, pB1; float mnA, mnB, alA, alB; bf16x8 pa0, pa1, pa2, pa3; const int NT = seq / KVBLK;
  ATT_SLOAD(0, 0); ATT_SWRITE(0, 0); __syncthreads();
  qkt(pA0, pA1, K_lds, qr, r32, hi); partialSM(pA0, pA1, m_reg, mnA, alA);
  ATT_SLOAD(1, KVBLK); ATT_SLOAD(0, 2 * KVBLK);
  ATT_SWRITE(1, 1); __syncthreads();
  for (int j = 1; j + 1 < NT; j += 2) {
    ATT_SBAR(); qkt(pB0, pB1, K_lds + SHM_K, qr, r32, hi);
    finishSM(pA0, pA1, alA, l_reg, pa0, pa1, pa2, pa3); ATT_SBAR();
    ATT_SLOAD(1, (j + 2) * KVBLK); ATT_SBAR();
    pv_d0(o, vb0, pa0, pa1, pa2, pa3); partialSM(pB0, pB1, m_reg, mnB, alB);
    __syncthreads(); ATT_SWRITE(0, 0);
    ATT_RESC(alB); __syncthreads();
    ATT_SBAR(); qkt(pA0, pA1, K_lds, qr, r32, hi);
    finishSM(pB0, pB1, alB, l_reg, pa0, pa1, pa2, pa3); ATT_SBAR();
    if (j + 3 < NT) ATT_SLOAD(0, (j + 3) * KVBLK); ATT_SBAR();
    pv_d0(o, vb0 + SHM_V, pa0, pa1, pa2, pa3); partialSM(pA0, pA1, m_reg, mnA, alA);
    __syncthreads(); ATT_SWRITE(1, 1);
    ATT_RESC(alA); __syncthreads();
  }
  ATT_SBAR(); qkt(pB0, pB1, K_lds + SHM_K, qr, r32, hi);
  finishSM(pA0, pA1, alA, l_reg, pa0, pa1, pa2, pa3); ATT_SBAR();
  pv_d0(o, vb0, pa0, pa1, pa2, pa3); partialSM(pB0, pB1, m_reg, mnB, alB);
  __syncthreads(); ATT_RESC(alB);
  finishSM(pB0, pB1, alB, l_reg, pa0, pa1, pa2, pa3); ATT_SBAR();
  pv_d0(o, vb0 + SHM_V, pa0, pa1, pa2, pa3);
  if (hi == 0) li_l[r32] = l_reg; asm volatile("s_waitcnt lgkmcnt(0)" ::: "memory");
  float rli[16];
#pragma unroll
  for (int r = 0; r < 16; ++r) rli[r] = __builtin_amdgcn_rcpf(li_l[crow(r, hi)]);
  { unsigned short* stg = (unsigned short*)(lds + L_OST) + wid * 2048;
#pragma unroll
    for (int r = 0; r < 16; ++r) { const int orow = crow(r, hi);
#pragma unroll
      for (int d0 = 0; d0 < 2; ++d0) stg[orow * 64 + d0 * 32 + r32] = (unsigned short)(cvtpk(o[d0][r] * rli[r], 0.f) & 0xffffu); }
    asm volatile("s_waitcnt lgkmcnt(0)" ::: "memory");
    unsigned short* Ow = Ob + (long)(wid * QBLK) * ldo;
#pragma unroll
    for (int i = 0; i < 4; ++i) { const int row = i * 8 + (lane >> 3), ch = lane & 7; const u32x4 v = *(const u32x4*)(stg + row * 64 + ch * 8); *(u32x4*)(Ow + (long)row * ldo + ch * 8) = v; } }
  __syncthreads();
#undef ATT_SLOAD
#undef ATT_SWRITE
#undef ATT_RESC
}
#undef ATT_SBAR
}


namespace att2 {
using bf16x8 = __attribute__((ext_vector_type(8))) short;
using s16x4  = __attribute__((ext_vector_type(4))) short;
using f32x16 = __attribute__((ext_vector_type(16))) float;
using u32x4  = __attribute__((ext_vector_type(4))) unsigned;
constexpr int NW = 8, QBLK = 32, KVBLK = 64, DQK = 96, DV = 64, NT = SEQ / KVBLK;
constexpr int NSLOT = 3, KNSLOT = 4, KSLOT = 12288, VSLOT = 8192;
constexpr int LDS_K = 0, LDS_V = KNSLOT * KSLOT, LDS_WS = LDS_V + NSLOT * VSLOT, LDS_OST = LDS_WS + NW * 64 * 4, LDS_BYTES_ = LDS_OST + NW * 4096;
__device__ __forceinline__ int crow(int r, int hi) { return (r & 3) + 8 * (r >> 2) + 4 * hi; }
#define A2_SBAR() __builtin_amdgcn_sched_barrier(0)
__device__ __forceinline__ void glds16(const void* gsrc, unsigned lds_dst) { unsigned keep;
  asm volatile("s_mov_b32 %0, m0\n\ts_mov_b32 m0, %2\n\ts_nop 0\n\tglobal_load_lds_dwordx4 %1, off\n\ts_mov_b32 m0, %0" : "=&s"(keep) : "v"(gsrc), "s"(lds_dst) : "memory"); }
typedef float f32x2_t __attribute__((ext_vector_type(2))); typedef __bf16 bf16x2_t __attribute__((ext_vector_type(2)));
__device__ __forceinline__ unsigned cvtpk_s(float lo, float hi) { f32x2_t v = {lo, hi}; bf16x2_t b = __builtin_convertvector(v, bf16x2_t); return __builtin_bit_cast(unsigned, b); }
#define A2_WAIT_BAR(N) asm volatile("s_waitcnt vmcnt(" #N ") lgkmcnt(0)\n\ts_barrier" ::: "memory")
#define A2_WAITB(N4, N8) do { if (lo4) { A2_WAIT_BAR(N4); } else { A2_WAIT_BAR(N8); } } while (0)
typedef __attribute__((address_space(3))) const char* lds_cptr;
typedef short v4i16_t __attribute__((ext_vector_type(4)));
__device__ __forceinline__ void kload2(bf16x8* kf, lds_cptr kp, int j) { kf[2 * j] = *(const __attribute__((address_space(3))) bf16x8*)(kp + j * 2048); kf[2 * j + 1] = *(const __attribute__((address_space(3))) bf16x8*)(kp + j * 2048 + 512); }
__device__ __forceinline__ s16x4 vtr(lds_cptr p) { return __builtin_bit_cast(s16x4, __builtin_amdgcn_ds_read_tr16_b64_v4i16((__attribute__((address_space(3))) v4i16_t*)p)); }

__device__ __forceinline__ void attn_unit(const unsigned short* Qb, const unsigned short* __restrict__ Kh, const unsigned short* __restrict__ Vh, unsigned short* Ob, int ldo, char* shm) {
  int tid_ = threadIdx.x; asm volatile("" : "+v"(tid_));
  const int tid = tid_, lane = tid & 63, r32 = lane & 31, hi = lane >> 5; const int wid = __builtin_amdgcn_readfirstlane(tid >> 6); const bool lo4 = wid < 4;
  const unsigned lds0 = (unsigned)(uintptr_t)shm;
  float* wsf = (float*)(shm + LDS_WS) + wid * 64;
  const unsigned short* ksrc = Kh + (long)lane * DQK + wid * 8;
  const unsigned short* ksrc2 = Kh + (long)lane * DQK + (8 + (wid & 3)) * 8;
  const unsigned short* vsrc = Vh + (long)(16 * (wid & 3) + (lane >> 2)) * DV + (wid >> 2) * 32 + (lane & 3) * 8;
  const unsigned kdst = lds0 + LDS_K + wid * 1024, kdst2 = lds0 + LDS_K + (8 + (wid & 3)) * 1024, vdst = lds0 + LDS_V + wid * 1024;
#define A2_DMA_K(t, slot) do { glds16(ksrc + (long)(t) * KVBLK * DQK, (unsigned)__builtin_amdgcn_readfirstlane(kdst + (slot) * KSLOT)); \
    if (lo4) glds16(ksrc2 + (long)(t) * KVBLK * DQK, (unsigned)__builtin_amdgcn_readfirstlane(kdst2 + (slot) * KSLOT)); } while (0)
#define A2_DMA_V(t, slot) glds16(vsrc + (long)(t) * KVBLK * DV, (unsigned)__builtin_amdgcn_readfirstlane(vdst + (slot) * VSLOT))
  const lds_cptr shm3 = (lds_cptr)shm; const lds_cptr kp0 = shm3 + LDS_K + hi * 1024 + r32 * 16;
  const lds_cptr vp0 = shm3 + LDS_V + ((lane >> 4) & 1) * 32 + (lane & 3) * 8 + (4 * hi + ((lane & 15) >> 2)) * 64;
  bf16x8 kf[12];
  A2_DMA_K(0, 0); A2_DMA_V(0, 0); A2_DMA_K(1, 1);
  bf16x8 qr[6];
  { const unsigned short* Qw = Qb + (long)(wid * QBLK + r32) * DQK + hi * 8;
#pragma unroll
    for (int d0 = 0; d0 < 6; ++d0) qr[d0] = *reinterpret_cast<const bf16x8*>(Qw + d0 * 16); }
  float l_reg = 0.f; f32x16 o[2]; o[0] = f32x16{}; o[1] = f32x16{};
  f32x16 pA0, pA1, pB0, pB1;
  int sl_prev = 0, sl_cur = 0, sl_next = 1;
  int kq1 = 1, kq3 = 3;
  const bool late = !lo4;
#define A2_ROT() do { sl_prev = sl_cur; sl_cur = sl_next; sl_next = (sl_next == NSLOT - 1) ? 0 : sl_next + 1; kq1 = (kq1 + 1) & 3; kq3 = (kq3 + 1) & 3; } while (0)
  A2_DMA_K(2, 2);
  A2_WAITB(5, 3);
  { pA0 = f32x16{}; pA1 = f32x16{};
#pragma unroll
    for (int d0 = 0; d0 < 6; ++d0) { const bf16x8 b0 = *(const __attribute__((address_space(3))) bf16x8*)(kp0 + d0 * 2048), b1 = *(const __attribute__((address_space(3))) bf16x8*)(kp0 + d0 * 2048 + 512);
      pA0 = __builtin_amdgcn_mfma_f32_32x32x16_bf16(b0, qr[d0], pA0, 0, 0, 0); pA1 = __builtin_amdgcn_mfma_f32_32x32x16_bf16(b1, qr[d0], pA1, 0, 0, 0); }
#pragma unroll
    for (int r = 0; r < 16; ++r) { pA0[r] = __builtin_amdgcn_exp2f(pA0[r]); pA1[r] = __builtin_amdgcn_exp2f(pA1[r]); } }
  A2_WAIT_BAR(0);
  A2_DMA_K(3, 3); A2_DMA_V(1, 1);
  A2_ROT();
  { const lds_cptr kp = kp0 + 1 * KSLOT;
#pragma unroll
    for (int j = 0; j < 6; ++j) kload2(kf, kp, j); }
  A2_WAITB(3, 2);
  s16x4 vlo[8], vhi[8]; u32x4 pw0, pw1, pw2, pw3;
#define A2_PKW(P, B) cvtpk_s(P[B], P[B + 1])
#define A2_PAF(k) __builtin_bit_cast(bf16x8, pw##k)
#define A2_VFR(i) (bf16x8){vlo[i][0], vlo[i][1], vlo[i][2], vlo[i][3], vhi[i][0], vhi[i][1], vhi[i][2], vhi[i][3]}
#define A2_PIN(x) asm volatile("" : "+v"(x))
#define A2_EX(v) __builtin_amdgcn_exp2f(v)
#define A2_VRD(i) do { vlo[i] = vtr(vp_ + (((i) >> 2) * 4096 + ((i) & 3) * 1024)); vhi[i] = vtr(vp_ + (((i) >> 2) * 4096 + ((i) & 3) * 1024 + 512)); } while (0)
#define A2_KRD(G, j) do { if (G) { kload2(kf, kp0 + kq1 * KSLOT, j); A2_SBAR(); } } while (0)
#define A2_GA3(MF, X0, X1, X2) do { MF; sacc += X0; sacc += X1; sacc += X2; A2_PIN(sacc); } while (0)
#define A2_GAPB(MF, X, B) do { MF; X[B] = A2_EX(X[B]); X[B + 1] = A2_EX(X[B + 1]); X[B + 2] = A2_EX(X[B + 2]); X[B + 3] = A2_EX(X[B + 3]); A2_PIN(X); A2_SBAR(); } while (0)
#define A2_MF(C, i, first) C = __builtin_amdgcn_mfma_f32_32x32x16_bf16(kf[i], qr[(i) >> 1], (first) ? f32x16{} : C, 0, 0, 0)
#define A2_STEP(C0, C1, P0, P1, t, GK, GV, GL, W) do { A2_SBAR(); \
    const lds_cptr vp_ = vp0 + sl_prev * VSLOT; \
    float sacc = (P0[0] + P0[1]); \
    A2_VRD(0); A2_SBAR(); A2_GA3(A2_MF(C0, 0, true),  P0[2],  P0[3],  P0[4]);  pw0[0] = A2_PKW(P0, 0);  A2_PIN(pw0); A2_SBAR(); \
    A2_VRD(4); A2_SBAR(); A2_GA3(A2_MF(C1, 1, true),  P0[5],  P0[6],  P0[7]);  pw0[1] = A2_PKW(P0, 2);  A2_PIN(pw0); A2_SBAR(); \
    A2_VRD(1); A2_SBAR(); A2_GA3(A2_MF(C0, 2, false), P0[8],  P0[9],  P0[10]); pw0[2] = A2_PKW(P0, 4);  A2_PIN(pw0); A2_SBAR(); \
    A2_VRD(5); A2_SBAR(); A2_GA3(A2_MF(C1, 3, false), P0[11], P0[12], P0[13]); pw0[3] = A2_PKW(P0, 6);  A2_PIN(pw0); A2_SBAR(); \
    A2_VRD(2); A2_SBAR(); A2_GA3(A2_MF(C0, 4, false), P0[14], P0[15], P1[0]);  pw1[0] = A2_PKW(P0, 8);  A2_PIN(pw1); A2_SBAR(); \
    A2_VRD(6); A2_SBAR(); A2_GA3(A2_MF(C1, 5, false), P1[1],  P1[2],  P1[3]);  pw1[1] = A2_PKW(P0, 10); A2_PIN(pw1); A2_SBAR(); \
    A2_VRD(3); A2_SBAR(); A2_GA3(A2_MF(C0, 6, false), P1[4],  P1[5],  P1[6]);  pw1[2] = A2_PKW(P0, 12); A2_PIN(pw1); A2_SBAR(); \
    A2_VRD(7); A2_SBAR(); A2_GA3(A2_MF(C1, 7, false), P1[7],  P1[8],  P1[9]);  pw1[3] = A2_PKW(P0, 14); A2_PIN(pw1); A2_SBAR(); \
    A2_GA3(A2_MF(C0, 8, false),  P1[10], P1[11], P1[12]); pw2[0] = A2_PKW(P1, 0);  pw2[1] = A2_PKW(P1, 2);  A2_PIN(pw2); A2_SBAR(); \
    A2_GA3(A2_MF(C1, 9, false),  P1[13], P1[14], P1[15]); pw2[2] = A2_PKW(P1, 4);  pw2[3] = A2_PKW(P1, 6);  A2_PIN(pw2); A2_SBAR(); \
    A2_MF(C0, 10, false); pw3[0] = A2_PKW(P1, 8);  pw3[1] = A2_PKW(P1, 10); A2_PIN(pw3); A2_SBAR(); \
    A2_MF(C1, 11, false); pw3[2] = A2_PKW(P1, 12); pw3[3] = A2_PKW(P1, 14); A2_PIN(pw3); A2_SBAR(); \
    l_reg += sacc; \
    if (GK) { A2_DMA_K((t) + 3, kq3); } if (GV) { A2_DMA_V((t) + 1, sl_next); } \
    if (late) { W; } \
    A2_SBAR(); \
    A2_GAPB(o[0] = __builtin_amdgcn_mfma_f32_32x32x16_bf16(A2_PAF(0), A2_VFR(0), o[0], 0, 0, 0), C0, 0); \
    A2_KRD(GL, 0); A2_GAPB(o[1] = __builtin_amdgcn_mfma_f32_32x32x16_bf16(A2_PAF(0), A2_VFR(4), o[1], 0, 0, 0), C0, 4); \
    A2_KRD(GL, 1); A2_GAPB(o[0] = __builtin_amdgcn_mfma_f32_32x32x16_bf16(A2_PAF(1), A2_VFR(1), o[0], 0, 0, 0), C0, 8); \
    A2_KRD(GL, 2); A2_GAPB(o[1] = __builtin_amdgcn_mfma_f32_32x32x16_bf16(A2_PAF(1), A2_VFR(5), o[1], 0, 0, 0), C0, 12); \
    A2_KRD(GL, 3); A2_GAPB(o[0] = __builtin_amdgcn_mfma_f32_32x32x16_bf16(A2_PAF(2), A2_VFR(2), o[0], 0, 0, 0), C1, 0); \
    A2_KRD(GL, 4); A2_GAPB(o[1] = __builtin_amdgcn_mfma_f32_32x32x16_bf16(A2_PAF(2), A2_VFR(6), o[1], 0, 0, 0), C1, 4); \
    A2_KRD(GL, 5); A2_GAPB(o[0] = __builtin_amdgcn_mfma_f32_32x32x16_bf16(A2_PAF(3), A2_VFR(3), o[0], 0, 0, 0), C1, 8); \
    A2_GAPB(o[1] = __builtin_amdgcn_mfma_f32_32x32x16_bf16(A2_PAF(3), A2_VFR(7), o[1], 0, 0, 0), C1, 12); \
  } while (0)
  int t = 1;
  for (; t + 5 < NT; t += 2) {
    A2_STEP(pB0, pB1, pA0, pA1, t, true, true, true, A2_WAITB(3, 2));     if (!late) { A2_WAITB(3, 2); } A2_ROT();
    A2_STEP(pA0, pA1, pB0, pB1, t + 1, true, true, true, A2_WAITB(3, 2)); if (!late) { A2_WAITB(3, 2); } A2_ROT();
  }
#define A2_ENDW(tt) do { if ((tt) + 3 < NT) { A2_WAITB(3, 2); } else if ((tt) + 2 < NT) { A2_WAIT_BAR(1); } else { A2_WAIT_BAR(0); } } while (0)
  for (; t + 1 < NT; t += 2) {
    A2_STEP(pB0, pB1, pA0, pA1, t, (t + 3 < NT), (t + 1 < NT), (t + 1 < NT), A2_ENDW(t));             if (!late) { A2_ENDW(t); }     A2_ROT();
    A2_STEP(pA0, pA1, pB0, pB1, t + 1, (t + 4 < NT), (t + 2 < NT), (t + 2 < NT), A2_ENDW(t + 1));     if (!late) { A2_ENDW(t + 1); } A2_ROT();
  }
  A2_STEP(pB0, pB1, pA0, pA1, NT - 1, false, false, false, (void)0);
  { float sacc = pB0[0] + pB0[1];
#pragma unroll
    for (int r = 2; r < 16; ++r) sacc += pB0[r];
#pragma unroll
    for (int r = 0; r < 16; ++r) sacc += pB1[r];
    l_reg += sacc;
    pw0 = (u32x4){A2_PKW(pB0, 0), A2_PKW(pB0, 2), A2_PKW(pB0, 4), A2_PKW(pB0, 6)}; pw1 = (u32x4){A2_PKW(pB0, 8), A2_PKW(pB0, 10), A2_PKW(pB0, 12), A2_PKW(pB0, 14)};
    pw2 = (u32x4){A2_PKW(pB1, 0), A2_PKW(pB1, 2), A2_PKW(pB1, 4), A2_PKW(pB1, 6)}; pw3 = (u32x4){A2_PKW(pB1, 8), A2_PKW(pB1, 10), A2_PKW(pB1, 12), A2_PKW(pB1, 14)};
    A2_SBAR();
    const lds_cptr vp_ = vp0 + sl_cur * VSLOT;
#pragma unroll
    for (int i = 0; i < 8; ++i) A2_VRD(i);
    o[0] = __builtin_amdgcn_mfma_f32_32x32x16_bf16(A2_PAF(0), A2_VFR(0), o[0], 0, 0, 0); o[1] = __builtin_amdgcn_mfma_f32_32x32x16_bf16(A2_PAF(0), A2_VFR(4), o[1], 0, 0, 0);
    o[0] = __builtin_amdgcn_mfma_f32_32x32x16_bf16(A2_PAF(1), A2_VFR(1), o[0], 0, 0, 0); o[1] = __builtin_amdgcn_mfma_f32_32x32x16_bf16(A2_PAF(1), A2_VFR(5), o[1], 0, 0, 0);
    o[0] = __builtin_amdgcn_mfma_f32_32x32x16_bf16(A2_PAF(2), A2_VFR(2), o[0], 0, 0, 0); o[1] = __builtin_amdgcn_mfma_f32_32x32x16_bf16(A2_PAF(2), A2_VFR(6), o[1], 0, 0, 0);
    o[0] = __builtin_amdgcn_mfma_f32_32x32x16_bf16(A2_PAF(3), A2_VFR(3), o[0], 0, 0, 0); o[1] = __builtin_amdgcn_mfma_f32_32x32x16_bf16(A2_PAF(3), A2_VFR(7), o[1], 0, 0, 0); }
  { auto rr = __builtin_amdgcn_permlane32_swap(__float_as_uint(l_reg), __float_as_uint(l_reg), false, false); l_reg = __uint_as_float(rr[0]) + __uint_as_float(rr[1]); }
  if (hi == 0) wsf[32 + r32] = l_reg;
  asm volatile("s_waitcnt lgkmcnt(0)" ::: "memory");
  float rli[16];
#pragma unroll
  for (int r = 0; r < 16; ++r) rli[r] = __builtin_amdgcn_rcpf(wsf[32 + crow(r, hi)]);
  { unsigned short* stg = (unsigned short*)(shm + LDS_OST) + wid * 2048;
#pragma unroll
    for (int r = 0; r < 16; ++r) { const int orow = crow(r, hi);
#pragma unroll
      for (int d0 = 0; d0 < 2; ++d0) stg[orow * 64 + d0 * 32 + r32] = (unsigned short)(cvtpk_s(o[d0][r] * rli[r], 0.f) & 0xffffu); }
    asm volatile("s_waitcnt lgkmcnt(0)" ::: "memory");
    unsigned short* Ow = Ob + (long)(wid * QBLK) * ldo;
#pragma unroll
    for (int i = 0; i < 4; ++i) { const int row = i * 8 + (lane >> 3), ch = lane & 7; const u32x4 v = *(const u32x4*)(stg + row * 64 + ch * 8); *(u32x4*)(Ow + (long)row * ldo + ch * 8) = v; } }
  asm volatile("s_waitcnt lgkmcnt(0)\n\ts_barrier" ::: "memory");
#undef A2_DMA_K
#undef A2_DMA_V
#undef A2_ROT
#undef A2_PKW
#undef A2_PAF
#undef A2_VFR
#undef A2_PIN
#undef A2_EX
#undef A2_VRD
#undef A2_KRD
#undef A2_GA3
#undef A2_GAPB
#undef A2_MF
#undef A2_STEP
#undef A2_ENDW
}
#undef A2_SBAR
#undef A2_WAIT_BAR
#undef A2_WAITB
}

__device__ __forceinline__ void p3_attn(const Args& a, unsigned char* lds, int bid, int G) {
    unsigned char* ws = a.ws;
    const bf16* QM = (const bf16*)(ws + WS_QM); const bf16* KM = (const bf16*)(ws + WS_KM); const bf16* VM = (const bf16*)(ws + WS_VM); bf16* MIX = (bf16*)(ws + WS_MIX);
    const int vcu = (G % 8 == 0) ? (bid % 8) * (G / 8) + bid / 8 : bid;
    float gq = 0.f, gk = 0.f;
    for (int i = 0; i < QKD; ++i) { gq = fmaxf(gq, fabsf(a.qng[i])); gk = fmaxf(gk, fabsf(a.kng[i])); }
    const bool fast = (float)QKD * gq * gk * ATT_C2 * 1.05f < 64.0f;
    for (int u = vcu; u < BH * (SEQ / 256); u += G) {
        const int bh = u / (SEQ / 256), qb = u % (SEQ / 256), b = bh / MH, h = bh % MH;
        if (fast) att2::attn_unit(QM + ((size_t)bh * SEQ + qb * 256) * QKD, KM + (size_t)bh * SEQ * QKD, VM + (size_t)bh * SEQ * VD, MIX + ((size_t)b * SEQ + qb * 256) * DM + RW + h * VD, DM, (char*)lds);
        else att::attn_unit(QM + ((size_t)bh * SEQ + qb * 256) * QKD, KM + (size_t)bh * SEQ * QKD, VM + (size_t)bh * SEQ * VD, MIX + ((size_t)b * SEQ + qb * 256) * DM + RW + h * VD, DM, SEQ, (char*)lds);
    }
}

namespace ret {
using bf16x8 = __attribute__((ext_vector_type(8))) short;
using s16x4  = __attribute__((ext_vector_type(4))) short;
using f32x4v = __attribute__((ext_vector_type(4))) float;
typedef short v4i16_t __attribute__((ext_vector_type(4)));
constexpr int L_Q = 0, L_K = 16384, L_V = 32768, L_SF = 49152, L_SB = 57344, L_ZF = 65536, L_ZB = 66048, L_BYTES = 66560;
constexpr int NSTEP = 47;
#define RET_BAR() asm volatile("s_waitcnt lgkmcnt(0)\n\ts_barrier" ::: "memory")
__device__ __forceinline__ int fsw(int m) { return ((m >> 2) & 1) | (((m >> 1) & 1) << 1) | ((((m >> 2) ^ (m >> 3)) & 1) << 2); }
__device__ __forceinline__ int sw(int m, int d) { return m * 128 + (((d >> 3) ^ fsw(m)) << 4) + (d & 7) * 2; }
__device__ __forceinline__ s16x4 trd(const unsigned char* p) { return __builtin_bit_cast(s16x4, __builtin_amdgcn_ds_read_tr16_b64_v4i16((LAS v4i16_t*)(p))); }
__device__ __forceinline__ bf16x8 cat8(s16x4 lo, s16x4 hi) { return (bf16x8){lo[0], lo[1], lo[2], lo[3], hi[0], hi[1], hi[2], hi[3]}; }
typedef float f32x2_t __attribute__((ext_vector_type(2))); typedef __bf16 bf16x2_t __attribute__((ext_vector_type(2)));
__device__ __forceinline__ unsigned cvt2(float lo, float hi) { f32x2_t v = {lo, hi}; bf16x2_t b = __builtin_convertvector(v, bf16x2_t); return __builtin_bit_cast(unsigned, b); }
__device__ __forceinline__ f32x4v mma(bf16x8 a_, bf16x8 b_, f32x4v c_) { return __builtin_amdgcn_mfma_f32_16x16x32_bf16(a_, b_, c_, 0, 0, 0); }
__device__ __forceinline__ void step_info(int k, int half, int& type, int& ch) {
  if (k < 31) { if (half == 0 || k < 15) { type = 0; ch = 31 - k; } else { type = 1; ch = k - 15; } }
  else { type = 2; ch = (k - 31) + 16 * half; }
}
__device__ __forceinline__ void kv_update(f32x4v (&acc)[2], const unsigned char* lds, const float* zt, int v, int u0, int g, int q, int p) {
  s16x4 alo[4], ahi[4], blo[4][2], bhi[4][2]; f32x4v z0[4], z1[4];
#pragma unroll
  for (int s = 0; s < 4; ++s) { const int mb = 32 * s + 8 * g;
    alo[s] = trd(lds + L_K + sw(mb + q, 16 * v + 4 * p)); ahi[s] = trd(lds + L_K + sw(mb + 4 + q, 16 * v + 4 * p));
    z0[s] = *(const f32x4v*)(zt + mb); z1[s] = *(const f32x4v*)(zt + mb + 4);
#pragma unroll
    for (int uu = 0; uu < 2; ++uu) { blo[s][uu] = trd(lds + L_V + sw(mb + q, 16 * (u0 + uu) + 4 * p)); bhi[s][uu] = trd(lds + L_V + sw(mb + 4 + q, 16 * (u0 + uu) + 4 * p)); } }
  __builtin_amdgcn_sched_barrier(0);
#pragma unroll
  for (int s = 0; s < 4; ++s) {
    v4u w; w.x = cvt2(bf2f((unsigned short)alo[s][0]) * z0[s][0], bf2f((unsigned short)alo[s][1]) * z0[s][1]); w.y = cvt2(bf2f((unsigned short)alo[s][2]) * z0[s][2], bf2f((unsigned short)alo[s][3]) * z0[s][3]);
    w.z = cvt2(bf2f((unsigned short)ahi[s][0]) * z1[s][0], bf2f((unsigned short)ahi[s][1]) * z1[s][1]); w.w = cvt2(bf2f((unsigned short)ahi[s][2]) * z1[s][2], bf2f((unsigned short)ahi[s][3]) * z1[s][3]);
    const bf16x8 az = __builtin_bit_cast(bf16x8, w);
#pragma unroll
    for (int uu = 0; uu < 2; ++uu) acc[uu] = mma(az, cat8(blo[s][uu], bhi[s][uu]), acc[uu]); }
}
__device__ __forceinline__ void item(const Args& a, unsigned char* lds, int it) {
  int tid_ = threadIdx.x; asm volatile("" : "+v"(tid_));
  const int tid = tid_, wid = tid >> 6, lane = tid & 63, l15 = lane & 15, g = lane >> 4, q = (lane >> 2) & 3, p = lane & 3;
  const int bh = it >> 1, half = it & 1, b = bh / RH, h = bh % RH;
  unsigned char* ws = a.ws;
  const bf16* pb = (const bf16*)(ws + WS_PROJ) + (size_t)b * SEQ * NINP + h * RD; bf16* MIX = (bf16*)(ws + WS_MIX) + (size_t)b * SEQ * DM + h * RD;
  unsigned char* RB = ws + WS_RB + (size_t)it * (16 * 8192);
  const float lgf = ((const float*)(ws + WS_LG))[h], lgb = ((const float*)(ws + WS_LG))[RH + h];
  float* zf = (float*)(lds + L_ZF); float* zb = (float*)(lds + L_ZB);
  __syncthreads();
  if (tid < 128) zf[tid] = exp2f(lgf * (float)(127 - tid)); else if (tid < 256) zb[tid - 128] = exp2f(lgb * (float)(tid - 128));
  if (half == 1) { const v4u z = {0u, 0u, 0u, 0u}; ((v4u*)(RB + 15 * 8192))[tid] = z; }
  const float dec_f = exp2f(lgf * 128.f), dec_b = exp2f(lgb * 128.f);
  float rf[4], rb[4];
#pragma unroll
  for (int r4 = 0; r4 < 4; ++r4) { rf[r4] = exp2f(-lgf * (float)r4); rb[r4] = exp2f(lgb * (float)r4); }
  const int v = wid >> 1, u0 = 2 * (wid & 1);
  f32x4v sf[2] = {}, sb[2] = {};
  const int srow = tid >> 3, sc = tid & 7;
  const int lw0 = sw(srow, 8 * sc), lw1 = sw(srow + 64, 8 * sc);
#define RET_ISSUE_L(ld, kk) do { int ty_, ch_; step_info((kk), half, ty_, ch_); const bf16* r0_ = pb + (size_t)(ch_ * RCH + srow) * NINP + sc * 8; const bf16* r1_ = r0_ + (size_t)64 * NINP; \
    ld[0] = *(const v4u*)(r0_ + C_K); ld[1] = *(const v4u*)(r1_ + C_K); ld[2] = *(const v4u*)(r0_ + C_V); ld[3] = *(const v4u*)(r1_ + C_V); } while (0)
#define RET_ISSUE_H(ld, kk) do { int ty_, ch_; step_info((kk), half, ty_, ch_); const bf16* r0_ = pb + (size_t)(ch_ * RCH + srow) * NINP + sc * 8; const bf16* r1_ = r0_ + (size_t)64 * NINP; \
    ld[0] = *(const v4u*)(r0_ + C_Q); ld[1] = *(const v4u*)(r1_ + C_Q); ld[2] = *(const v4u*)(r0_ + C_K); ld[3] = *(const v4u*)(r1_ + C_K); ld[4] = *(const v4u*)(r0_ + C_V); ld[5] = *(const v4u*)(r1_ + C_V); \
    if ((kk) > 31) ld[6] = *(const v4u*)(RB + (size_t)(ch_ - 16 * half) * 8192 + tid * 16); } while (0)
  v4u ldH[7];
  { v4u ldA[4], ldB[4];
    RET_ISSUE_L(ldA, 0); RET_ISSUE_L(ldB, 1);
    auto light = [&](const int k, v4u (&ld)[4]) __attribute__((always_inline)) {
      int type, ch; step_info(k, half, type, ch);
      *(v4u*)(lds + L_K + lw0) = ld[0]; *(v4u*)(lds + L_K + lw1) = ld[1]; *(v4u*)(lds + L_V + lw0) = ld[2]; *(v4u*)(lds + L_V + lw1) = ld[3];
      RET_BAR();
      if (k + 2 < 31) RET_ISSUE_L(ld, k + 2);
      if (k == 29) RET_ISSUE_H(ldH, 31);
      if (type == 0) { sb[0] *= dec_b; sb[1] *= dec_b; kv_update(sb, lds, zb, v, u0, g, q, p);
        const int slot = ch - 1 - 16 * half;
        if (slot >= 0 && slot < 16) {
#pragma unroll
          for (int uu = 0; uu < 2; ++uu) { v2u w; w.x = cvt2(sb[uu][0], sb[uu][1]); w.y = cvt2(sb[uu][2], sb[uu][3]); *(v2u*)(RB + (size_t)slot * 8192 + ((16 * (u0 + uu) + l15) * 64 + 16 * v + 4 * g) * 2) = w; } } }
      else { sf[0] *= dec_f; sf[1] *= dec_f; kv_update(sf, lds, zf, v, u0, g, q, p); }
      RET_BAR();
    };
    for (int k = 0; k + 1 < 31; k += 2) { light(k, ldA); light(k + 1, ldB); }
    light(30, ldA); }
  __syncthreads();
  for (int k = 31; k < NSTEP; ++k) {
    int type, ch; step_info(k, half, type, ch);
    { *(v4u*)(lds + L_Q + lw0) = ldH[0]; *(v4u*)(lds + L_Q + lw1) = ldH[1];
      const v4u rb = (k > 31) ? ldH[6] : *(const v4u*)(RB + (size_t)(ch - 16 * half) * 8192 + tid * 16); *(v4u*)(lds + L_SB + lw0) = rb;
#pragma unroll
      for (int uu = 0; uu < 2; ++uu) { v2u w; w.x = cvt2(sf[uu][0], sf[uu][1]); w.y = cvt2(sf[uu][2], sf[uu][3]); *(v2u*)(lds + L_SF + sw(16 * (u0 + uu) + l15, 16 * v + 4 * g)) = w; } }
    *(v4u*)(lds + L_K + lw0) = ldH[2]; *(v4u*)(lds + L_K + lw1) = ldH[3]; *(v4u*)(lds + L_V + lw0) = ldH[4]; *(v4u*)(lds + L_V + lw1) = ldH[5];
    RET_BAR();
    if (k + 1 < NSTEP) RET_ISSUE_H(ldH, k + 1);
    {
      const int n = 16 * wid + l15;
      bf16x8 qf[2];
#pragma unroll
      for (int s = 0; s < 2; ++s) qf[s] = *(const bf16x8*)(lds + L_Q + sw(n, 32 * s + 8 * g));
      const int tok = ch * RCH + n; const bf16* gp = pb + (size_t)tok * NINP + C_G + 4 * g; v2u gwv[4];
#pragma unroll
      for (int u = 0; u < 4; ++u) gwv[u] = *(const v2u*)(gp + 16 * u);
      f32x4v st[8];
#pragma unroll
      for (int th = 0; th < 2; ++th) { bf16x8 kf[4][2];
#pragma unroll
        for (int t4 = 0; t4 < 4; ++t4)
#pragma unroll
          for (int s = 0; s < 2; ++s) kf[t4][s] = *(const bf16x8*)(lds + L_K + sw(16 * (4 * th + t4) + l15, 32 * s + 8 * g));
        __builtin_amdgcn_sched_barrier(0);
#pragma unroll
        for (int t4 = 0; t4 < 4; ++t4) { st[4 * th + t4] = (f32x4v){0.f, 0.f, 0.f, 0.f};
#pragma unroll
          for (int s = 0; s < 2; ++s) st[4 * th + t4] = mma(kf[t4][s], qf[s], st[4 * th + t4]); }
        __builtin_amdgcn_sched_barrier(0); }
#pragma unroll
      for (int t = 0; t < 8; ++t) {
        const float ft = __builtin_amdgcn_exp2f(lgf * (float)(n - 4 * g - 16 * t)), bt = __builtin_amdgcn_exp2f(lgb * (float)(16 * t + 4 * g - n));
#pragma unroll
        for (int r = 0; r < 4; ++r) st[t][r] *= (16 * t + 4 * g + r <= n) ? ft * rf[r] : bt * rb[r]; }
      f32x4v oi[4] = {};
#pragma unroll
      for (int sh = 0; sh < 2; ++sh) { s16x4 vlo[2][4], vhi[2][4];
#pragma unroll
        for (int s2 = 0; s2 < 2; ++s2)
#pragma unroll
          for (int u = 0; u < 4; ++u) { const int s = 2 * sh + s2; vlo[s2][u] = trd(lds + L_V + sw(32 * s + 4 * g + q, 16 * u + 4 * p)); vhi[s2][u] = trd(lds + L_V + sw(32 * s + 16 + 4 * g + q, 16 * u + 4 * p)); }
        __builtin_amdgcn_sched_barrier(0);
#pragma unroll
        for (int s2 = 0; s2 < 2; ++s2) { const int s = 2 * sh + s2; v4u w; w.x = cvt2(st[2 * s][0], st[2 * s][1]); w.y = cvt2(st[2 * s][2], st[2 * s][3]); w.z = cvt2(st[2 * s + 1][0], st[2 * s + 1][1]); w.w = cvt2(st[2 * s + 1][2], st[2 * s + 1][3]);
          const bf16x8 pf = __builtin_bit_cast(bf16x8, w);
#pragma unroll
          for (int u = 0; u < 4; ++u) oi[u] = mma(cat8(vlo[s2][u], vhi[s2][u]), pf, oi[u]); }
        __builtin_amdgcn_sched_barrier(0); }
      f32x4v cf[4] = {}, cb[4] = {};
#pragma unroll
      for (int s = 0; s < 2; ++s) { bf16x8 af[4], ab[4];
#pragma unroll
        for (int u = 0; u < 4; ++u) { af[u] = *(const bf16x8*)(lds + L_SF + sw(16 * u + l15, 32 * s + 8 * g)); ab[u] = *(const bf16x8*)(lds + L_SB + sw(16 * u + l15, 32 * s + 8 * g)); }
        __builtin_amdgcn_sched_barrier(0);
#pragma unroll
        for (int u = 0; u < 4; ++u) { cf[u] = mma(af[u], qf[s], cf[u]); cb[u] = mma(ab[u], qf[s], cb[u]); }
        __builtin_amdgcn_sched_barrier(0); }
      const float xf = exp2f(lgf * (float)(n + 1)), xb = exp2f(lgb * (float)(RCH - n));
      float s1 = 0.f;
#pragma unroll
      for (int u = 0; u < 4; ++u)
#pragma unroll
        for (int r = 0; r < 4; ++r) { oi[u][r] += xf * cf[u][r] + xb * cb[u][r]; s1 += oi[u][r]; }
      s1 += __shfl_xor(s1, 16); s1 += __shfl_xor(s1, 32);
      const float mu = s1 * (1.f / 64.f); float s2 = 0.f;
#pragma unroll
      for (int u = 0; u < 4; ++u)
#pragma unroll
        for (int r = 0; r < 4; ++r) { const float d = oi[u][r] - mu; s2 += d * d; }
      s2 += __shfl_xor(s2, 16); s2 += __shfl_xor(s2, 32);
      const float rs = __builtin_amdgcn_rsqf(s2 * (1.f / 64.f) + GN_EPS);
      bf16* op = MIX + (size_t)tok * DM + 4 * g;
#pragma unroll
      for (int u = 0; u < 4; ++u) { const v2u gw = gwv[u]; const float g0 = bflo(gw.x), g1 = bfhi(gw.x), g2 = bflo(gw.y), g3 = bfhi(gw.y);
#define RET_SILU(x) ((x) * __builtin_amdgcn_rcpf(1.0f + __builtin_amdgcn_exp2f(-1.4426950408889634f * (x))))
        const float y0 = RET_SILU(g0) * (oi[u][0] - mu) * rs, y1 = RET_SILU(g1) * (oi[u][1] - mu) * rs, y2 = RET_SILU(g2) * (oi[u][2] - mu) * rs, y3 = RET_SILU(g3) * (oi[u][3] - mu) * rs;
#undef RET_SILU
        v2u w; w.x = cvt2(y0, y1); w.y = cvt2(y2, y3); *(v2u*)(op + 16 * u) = w; }
        }
    sf[0] *= dec_f; sf[1] *= dec_f; kv_update(sf, lds, zf, v, u0, g, q, p);
    RET_BAR();
  }
#undef RET_ISSUE_L
#undef RET_ISSUE_H
}
__device__ __forceinline__ void run(const Args& a, unsigned char* lds, int bid, int G) {
  const int vcu = (G % 8 == 0) ? (bid % 8) * (G / 8) + bid / 8 : bid;
  for (int it = vcu; it < BH * 2; it += G) item(a, lds, it);
}
#undef RET_BAR
}

#define GAS __attribute__((address_space(1)))
typedef GAS unsigned gu32;
#define RLX_AGENT __ATOMIC_RELAXED, __HIP_MEMORY_SCOPE_AGENT
constexpr int CW_BAR = 4096;
constexpr size_t CTL_ZERO_BYTES = 65536;
#define XB_TMO      128
#define XB_XCNT(j)  (256  + 64 * (j))
#define XB_XSUB(j)  (1280 + 64 * (j))
#define XB_XGEN(j)  (2304 + 64 * (j))
#define XB_TOP      3328
#define XB_TOPGEN   3392
#define XCD_BAR_WORDS 3456
#define XB_SPIN_CAP (1u << 18)

__device__ __forceinline__ unsigned xb_ld(unsigned* p)              { return __hip_atomic_load(p, __ATOMIC_RELAXED, __HIP_MEMORY_SCOPE_AGENT); }
__device__ __forceinline__ unsigned xb_add(unsigned* p, unsigned v) { return __hip_atomic_fetch_add(p, v, __ATOMIC_RELAXED, __HIP_MEMORY_SCOPE_AGENT); }
__device__ __forceinline__ unsigned xb_xcc_id() { return (unsigned)__builtin_amdgcn_s_getreg((3 << 11) | 20) & 0xFu; }
#define XB_SPIN(cond, bar) do { unsigned _sp = 0; while (cond) { __builtin_amdgcn_s_sleep(1); \
    if ((++_sp & 255u) == 0u) { if (xb_ld(&(bar)[XB_TMO])) break; if (_sp > XB_SPIN_CAP) { atomicAdd(&(bar)[XB_TMO], 1u); break; } } } } while (0)

struct XcdBarrier {
    unsigned* bar; unsigned x;
    volatile LAS unsigned* st;
};

__device__ __forceinline__ XcdBarrier xcd_barrier_post(unsigned* bar, volatile LAS unsigned* st) {
    XcdBarrier b; b.bar = bar; b.x = xb_xcc_id(); b.st = st;
    if (threadIdx.x == 0) (void)xb_add(&bar[XB_XCNT(b.x)], 1u);
    return b;
}
__device__ __forceinline__ void xcd_barrier_complete(unsigned* bar, unsigned x, unsigned& nloc, unsigned& nx) {
    const unsigned G = gridDim.x * gridDim.y * gridDim.z;
    unsigned sum, cnt, mine, sp = 0u;
    for (;;) {
        sum = 0u; cnt = 0u; mine = 0u;
#pragma unroll
        for (unsigned j = 0; j < 16; ++j) { const unsigned c = xb_ld(&bar[XB_XCNT(j)]); sum += c; cnt += (c > 0u) ? 1u : 0u; mine = (j == x) ? c : mine; }
        if (sum == G) break;
        __builtin_amdgcn_s_sleep(1);
        if ((++sp & 255u) == 0u) { if (xb_ld(&bar[XB_TMO])) break; if (sp > XB_SPIN_CAP) { atomicAdd(&bar[XB_TMO], 1u); break; } }
    }
    nloc = mine > 0u ? mine : 1u; nx = cnt > 0u ? cnt : 1u;
}

__device__ __forceinline__ void xcd_barrier(const XcdBarrier& b) {
    asm volatile("s_waitcnt vmcnt(0)" ::: "memory");
    __syncthreads();
    if (threadIdx.x == 0) {
        unsigned* bar = b.bar;
        __builtin_amdgcn_s_waitcnt(0);
        unsigned nloc = b.st[0], nx = b.st[1];
        if (nloc == 0u) { xcd_barrier_complete(bar, b.x, nloc, nx); b.st[0] = nloc; b.st[1] = nx; }
        const unsigned old = xb_add(&bar[XB_XSUB(b.x)], 1u);
        const unsigned gen = old / nloc;
        if (old + 1u == (gen + 1u) * nloc) {
            __builtin_amdgcn_fence(__ATOMIC_RELEASE, "agent");
            asm volatile("s_waitcnt vmcnt(0)" ::: "memory");
            const unsigned og = xb_add(&bar[XB_TOP], 1u);
            const unsigned tg = og / nx;
            if (og + 1u == (tg + 1u) * nx) xb_add(&bar[XB_TOPGEN], 1u);
            else XB_SPIN(xb_ld(&bar[XB_TOPGEN]) == tg, bar);
            __builtin_amdgcn_fence(__ATOMIC_ACQUIRE, "agent");
            xb_add(&bar[XB_XGEN(b.x)], 1u);
            asm volatile("s_waitcnt vmcnt(0)" ::: "memory");
        } else {
            XB_SPIN(xb_ld(&bar[XB_XGEN(b.x)]) == gen, bar);
            __builtin_amdgcn_fence(__ATOMIC_ACQUIRE, "agent");
            asm volatile("s_waitcnt vmcnt(0)" ::: "memory");
        }
    }
    __syncthreads();
}

#ifndef EPI1
#define EPI1 EpiProj3
#define EPI1_ARG a.pos
#endif
#ifndef EPI1_ARG
#define EPI1_ARG (const float*)(ws + WS_ROT)
#endif
#ifndef EPI4
#define EPI4 EpiResid5
#endif
#ifndef EPI5
#define EPI5 EpiSwiGLU3
#endif
#ifndef EPI5_ARGS
#define EPI5_ARGS (const LAS int*)(ldsl + pg8::STAGE_BYTES), (const LAS float*)(ldsl + pg8::STAGE_BYTES + 1024)
#endif
#ifndef EPI6
#define EPI6 EpiOut5
#endif
#ifndef PG8_SP2
#define PG8_SP2 true
#endif
#ifndef PG8_ALIGN
#define PG8_ALIGN true
#endif
__global__ void __launch_bounds__(NTHR, 2) fwd_kernel(Args a) {
    extern __shared__ __attribute__((aligned(16))) unsigned char lds[];
    cg::grid_group grid = cg::this_grid();
    LAS unsigned char* ldsl = (LAS unsigned char*)lds;
    const int tid = threadIdx.x, lane = tid & 63, wave = __builtin_amdgcn_readfirstlane(tid >> 6);
    const int G = gridDim.x, bid = blockIdx.x;
    const int gw = bid * NWAVES + wave, NGW = G * NWAVES;
    unsigned char* ws = a.ws;
    volatile LAS unsigned* bst = (volatile LAS unsigned*)(ldsl + LDS_BYTES - 64);
    if (tid == 0) { bst[0] = 0u; bst[1] = 0u; }
    __syncthreads();
    const XcdBarrier xbar = xcd_barrier_post((unsigned*)ws + CW_BAR, bst);
    bf16* XN = (bf16*)(ws + WS_XN); bf16* PROJ = (bf16*)(ws + WS_PROJ); bf16* MIX = (bf16*)(ws + WS_MIX); bf16* ACT = (bf16*)(ws + WS_ACT); float* SSQ = (float*)(ws + WS_SSQ);

    p0_prologue(a, ldsl, gw, NGW, wave, lane);
    if (gridDim.y == 0x7fff) grid.sync();
    xcd_barrier(xbar);
    { pg8::Gemm g{XN, (const bf16*)(ws + WS_WIN), M, NINP, DM}; pg8::StaticOrder S; S.init(M, NINP, G, bid);
      pg8::EPI1 E{PROJ, NINP, EPI1_ARG};
      pg8::gemm_phase<pg8::EPI1, pg8::StaticOrder, PG8_ALIGN, PG8_SP2>(ldsl, g, S, E); }
    xcd_barrier(xbar);
    p2f::run(a, lds, bid, G);
    xcd_barrier(xbar);
    ret::run(a, lds, bid, G);
    p3_attn(a, lds, bid, G);
    xcd_barrier(xbar);
    { pg8::Gemm g{MIX, (const bf16*)(ws + WS_WO), M, DM, DM}; pg8::StaticOrder S; S.init(M, DM, G, bid);
      pg8::EPI4 E{a.x, XN, SSQ, DM};
      pg8::gemm_phase<pg8::EPI4, pg8::StaticOrder, PG8_ALIGN, PG8_SP2>(ldsl, g, S, E); }
    xcd_barrier(xbar);
    { float* RSTD = (float*)(ws + WS_RSTD); LAS int* plist = (LAS int*)(ldsl + pg8::STAGE_BYTES); LAS float* rtab = (LAS float*)(ldsl + pg8::STAGE_BYTES + 1024);
      if (tid == 0) plist[0] = 0;
      __syncthreads();
      { pg8::StaticOrder S5; S5.init(M, NGU, G, bid); pg8::Unit u5, up;
        for (int i = tid; S5.next(i, u5); i += NTHR) { const bool fresh = (i == 0) || (S5.next(i - 1, up) && up.pm != u5.pm);
            if (fresh) { const int n = __hip_atomic_fetch_add((int*)plist, 1, __ATOMIC_RELAXED, __HIP_MEMORY_SCOPE_WORKGROUP); if (n < 16) plist[1 + n] = u5.pm; } } }
      __syncthreads();
      const int np = plist[0] < 16 ? plist[0] : 16; if (tid == 0) plist[0] = np;
      for (int k = tid >> 8; k < np; k += 2) { const int r = plist[1 + k] * 256 + (tid & 255);
          const f32x4* sp = (const f32x4*)(SSQ + (size_t)r * 16); const f32x4 s0 = sp[0], s1 = sp[1], s2 = sp[2], s3 = sp[3];
          const float ss = ((s0[0] + s0[1]) + (s0[2] + s0[3])) + ((s1[0] + s1[1]) + (s1[2] + s1[3])) + ((s2[0] + s2[1]) + (s2[2] + s2[3])) + ((s3[0] + s3[1]) + (s3[2] + s3[3]));
          const float rv_ = 1.0f / sqrtf(ss * (1.f / DM) + EPS); RSTD[r] = rv_; rtab[k * 256 + (tid & 255)] = rv_; }
      asm volatile("s_waitcnt vmcnt(0)" ::: "memory");
      __syncthreads(); }
    { pg8::Gemm g{XN, (const bf16*)(ws + WS_WGU), M, NGU, DM}; pg8::StaticOrder S; S.init(M, NGU, G, bid);
      pg8::EPI5 E{ACT, DFF, EPI5_ARGS};
      pg8::gemm_phase<pg8::EPI5, pg8::StaticOrder, PG8_ALIGN, PG8_SP2>(ldsl, g, S, E); }
    xcd_barrier(xbar);
    { pg8::Gemm g{ACT, (const bf16*)(ws + WS_WDN), M, DM, DFF}; pg8::StaticOrder S; S.init(M, DM, G, bid);
      pg8::EPI6 E{XN, a.out, DM};
      pg8::gemm_phase<pg8::EPI6, pg8::StaticOrder, PG8_ALIGN, PG8_SP2>(ldsl, g, S, E); }
}

extern "C" void kernel_launch(void* const* d_in, const int* in_sizes, int n_in, void* d_out, int out_size, void* d_ws, size_t ws_size, hipStream_t stream) {
    static int grid = 0;
    if (grid == 0) {
        if (n_in != 17 || in_sizes[0] != M * DM || out_size != M * DM || ws_size < WS_END) { fprintf(stderr, "kernel_launch: unexpected shapes: n_in %d in0 %d out %d ws %zu (need >= %zu)\n", n_in, n_in > 0 ? in_sizes[0] : -1, out_size, ws_size, (size_t)WS_END); grid = -1; return; }
        int dev = 0, cus = 0, per_cu = 0;
        if (hipGetDevice(&dev) != hipSuccess || hipDeviceGetAttribute(&cus, hipDeviceAttributeMultiprocessorCount, dev) != hipSuccess) { fprintf(stderr, "kernel_launch: device query failed\n"); grid = -1; return; }
        if (hipFuncSetAttribute((const void*)fwd_kernel, hipFuncAttributeMaxDynamicSharedMemorySize, LDS_BYTES) != hipSuccess) { fprintf(stderr, "kernel_launch: hipFuncSetAttribute failed\n"); grid = -1; return; }
        if (hipOccupancyMaxActiveBlocksPerMultiprocessor(&per_cu, (const void*)fwd_kernel, NTHR, LDS_BYTES) != hipSuccess || per_cu < 1) { fprintf(stderr, "kernel_launch: occupancy query says %d blocks per CU\n", per_cu); (void)hipGetLastError(); per_cu = 1; }
        grid = cus * 1;
        fprintf(stderr, "kernel_launch: %d CUs, occupancy %d block(s)/CU, grid %d\n", cus, per_cu, grid);
    }
    if (grid < 0) return;
    if (hipMemsetAsync(d_ws, 0, CTL_ZERO_BYTES, stream) != hipSuccess) { fprintf(stderr, "kernel_launch: hipMemsetAsync failed\n"); return; }
    Args a{};
    a.x = (const float*)d_in[0]; a.pos = (const int*)d_in[1]; a.g1 = (const float*)d_in[2]; a.w_in = (const float*)d_in[3]; a.lf = (const float*)d_in[4]; a.lb = (const float*)d_in[5];
    a.qag = (const float*)d_in[6]; a.w_uq = (const float*)d_in[7]; a.kvag = (const float*)d_in[8]; a.w_ukv = (const float*)d_in[9]; a.qng = (const float*)d_in[10]; a.kng = (const float*)d_in[11];
    a.w_o = (const float*)d_in[12]; a.g2 = (const float*)d_in[13]; a.w_gate = (const float*)d_in[14]; a.w_up = (const float*)d_in[15]; a.w_down = (const float*)d_in[16];
    a.out = (float*)d_out; a.ws = (unsigned char*)d_ws;
    void* args[] = {&a};
    const hipError_t e = hipLaunchCooperativeKernel((const void*)fwd_kernel, dim3(grid), dim3(NTHR), args, LDS_BYTES, stream);
    if (e != hipSuccess) fprintf(stderr, "kernel_launch: cooperative launch failed: %s (grid %d)\n", hipGetErrorString(e), grid);
}
```

```cpp
#include <hip/hip_runtime.h>
#include <hip/hip_cooperative_groups.h>
#include <cstdio>
#include <cstdint>
#include <cmath>
namespace cg = cooperative_groups;
namespace pg8 {
#define PG8_LAS __attribute__((address_space(3)))
typedef unsigned short bf16_t;
typedef short bf16x8 __attribute__((ext_vector_type(8)));
typedef float f32x4 __attribute__((ext_vector_type(4)));
typedef unsigned u32x4 __attribute__((ext_vector_type(4)));
constexpr int BM = 256, BK = 64, HALF = 128, HTB = HALF * BK * 2  , STAGE_BYTES = 8 * HTB, NXCD = 8, WGM = 8;

__host__ __device__ __forceinline__ int lds_byte(int r, int c) { const int st = (r >> 4) * 2 + (c >> 5), rr = r & 15, cc = c & 31, ob = rr * 64 + cc * 2; return st * 1024 + (ob ^ (((ob >> 9) & 1) << 5)); }
__host__ __device__ __forceinline__ void stage_rc(int b, int& R, int& C) { const int st = b / 1024, sb = b % 1024, swz = sb ^ (((sb >> 9) & 1) << 5); R = (st >> 1) * 16 + swz / 64; C = (st & 1) * 32 + (swz % 64) / 2; }
__host__ __device__ __forceinline__ int perm32(int rho) { const int n = rho >> 4, i = rho & 15; return 8 * (i >> 2) + 4 * n + (i & 3); }

struct Unit { int pm, pn; };
struct Gemm { const bf16_t* A; const bf16_t* Bt; int M, N, K; };

struct StaticOrder {
    int nM, nN, nwg, G, c;
    __host__ __device__ void init(int M, int N, int G_, int c_) { nM = M / BM; nN = N / BM; nwg = nM * nN; G = G_; c = c_; }
    __host__ __device__ bool next(int i, Unit& u) const {
        const long L = (long)i * G + c; if (L >= nwg) return false;
        int wgid = (int)L; { const int q = nwg / NXCD, r = nwg % NXCD, xcd = wgid % NXCD, off = wgid / NXCD; wgid = (xcd < r ? xcd * (q + 1) : r * (q + 1) + (xcd - r) * q) + off; }
        const int nig = WGM * nN, gid = wgid / nig, fm = gid * WGM, gsz = (nM - fm) < WGM ? (nM - fm) : WGM;
        u.pm = fm + ((wgid % nig) % gsz); u.pn = (wgid % nig) / gsz; return true;
    }
    __device__ __forceinline__ void a_ready(const Unit&) const {}
    __device__ __forceinline__ void done(const Unit&) const {}
};

__device__ __forceinline__ unsigned cvt_pk_bf16(float lo, float hi) { unsigned r; asm volatile("v_cvt_pk_bf16_f32 %0, %1, %2" : "=v"(r) : "v"(lo), "v"(hi)); return r; }
typedef float f32x2 __attribute__((ext_vector_type(2)));
__device__ __forceinline__ f32x2 gelu_pk(f32x2 v) {
    const f32x2 av = __builtin_elementwise_abs(v), d = av * 0.2316418882f + 1.0f;
    f32x2 t; t.x = __builtin_amdgcn_rcpf(d.x); t.y = __builtin_amdgcn_rcpf(d.y);
    f32x2 q = t * 0.5307027145f + (-0.7265760135f); q = q * t + 0.7107068705f; q = q * t + (-0.142248368f); q = q * t + 0.127414796f; q = q * t;
    const f32x2 s = (v * v) * (-0.72134752044f);
    f32x2 e; e.x = __builtin_amdgcn_exp2f(s.x); e.y = __builtin_amdgcn_exp2f(s.y);
    const f32x2 m = v * (q * e), r = v - m;
    f32x2 o; o.x = v.x < 0.f ? m.x : r.x; o.y = v.y < 0.f ? m.y : r.y; return o;
}

template <int ACT  > struct EpiBf16 {
    static constexpr bool PERM = true, AFTER_DRAIN = false; static_assert(ACT == 0 || ACT == 1, "EpiBf16: ACT is 0 (none) or 1 (gelu_pk)");
    bf16_t* O; int ldc; const float* bias; int split_cols; size_t split_stride; float scale0;
    __device__ __forceinline__ void operator()(const f32x4 (&acc)[2][2][4][2], const Unit& u, int wr, int wc, int fr, int fq) const {
        const int row0 = u.pm * BM + wr * 64 + fr; int colt = u.pn * BM; bf16_t* base = O;
        float sc = 1.f; if (split_cols) { const int t = colt / split_cols; base += (size_t)t * split_stride; colt -= t * split_cols; if (t == 0) sc = scale0; }
        const int col0 = colt + wc * 32 + 8 * fq, bcol0 = u.pn * BM + wc * 32 + 8 * fq;
        f32x4 bv[2][2];
#pragma unroll
        for (int bj = 0; bj < 2; ++bj)
#pragma unroll
            for (int n = 0; n < 2; ++n) bv[bj][n] = bias ? *(const f32x4*)(bias + bcol0 + bj * HALF + 4 * n) : (f32x4){0.f, 0.f, 0.f, 0.f};
#pragma unroll
        for (int ai = 0; ai < 2; ++ai)
#pragma unroll
            for (int m = 0; m < 4; ++m) { bf16_t* rowp = base + (size_t)(row0 + ai * HALF + m * 16) * ldc + col0;
#pragma unroll
                for (int bj = 0; bj < 2; ++bj) { f32x4 v0 = acc[ai][bj][m][0] + bv[bj][0], v1 = acc[ai][bj][m][1] + bv[bj][1];
                    if (ACT == 1) { f32x2 a = gelu_pk((f32x2){v0[0], v0[1]}), b = gelu_pk((f32x2){v0[2], v0[3]}), c = gelu_pk((f32x2){v1[0], v1[1]}), d = gelu_pk((f32x2){v1[2], v1[3]});
                        v0 = (f32x4){a.x, a.y, b.x, b.y}; v1 = (f32x4){c.x, c.y, d.x, d.y}; }
                    v0 = v0 * sc; v1 = v1 * sc; u32x4 w; w.x = cvt_pk_bf16(v0[0], v0[1]); w.y = cvt_pk_bf16(v0[2], v0[3]); w.z = cvt_pk_bf16(v1[0], v1[1]); w.w = cvt_pk_bf16(v1[2], v1[3]);
                    *(u32x4*)(rowp + bj * HALF) = w; } }
    }
};
#define ZF_P4 true
#define ZF_P6 true
#ifndef ZF_DEFAULT
#define ZF_DEFAULT false
#endif
#ifndef ZF_P1
#define ZF_P1 true
#endif
#ifndef ZF_P5
#define ZF_P5 true
#endif
#ifndef ZF_P4
#define ZF_P4 false
#endif
#ifndef ZF_P6
#define ZF_P6 false
#endif
typedef unsigned u32x2 __attribute__((ext_vector_type(2)));
struct EpiResid {
    static constexpr bool PERM = false, AFTER_DRAIN = false; static constexpr int LANE_T = 0; static constexpr bool ZFIRST = ZF_DEFAULT;
    const float* base; float* out; bf16_t* xb; float* ssq; int ldc;
    __device__ __forceinline__ void operator()(const f32x4 (&acc)[2][2][4][2], const Unit& u, int wr, int wc, int fr, int fq) const {
        const int col0 = u.pn * BM + wc * 32 + 4 * fq;
#pragma unroll
        for (int ai = 0; ai < 2; ++ai)
#pragma unroll
            for (int m = 0; m < 4; ++m) { const int r = u.pm * BM + ai * HALF + wr * 64 + m * 16 + fr; const size_t off = (size_t)r * ldc + col0; float s = 0.f;
#pragma unroll
                for (int bj = 0; bj < 2; ++bj)
#pragma unroll
                    for (int n = 0; n < 2; ++n) { const f32x4 bs = *(const f32x4*)(base + off + bj * HALF + n * 16); const f32x4 o = bs + acc[ai][bj][m][n];
                        *(f32x4*)(out + off + bj * HALF + n * 16) = o; u32x2 w; w.x = cvt_pk_bf16(o[0], o[1]); w.y = cvt_pk_bf16(o[2], o[3]);
                        *(u32x2*)(xb + off + bj * HALF + n * 16) = w; s += (o[0] * o[0] + o[1] * o[1]) + (o[2] * o[2] + o[3] * o[3]); }
                s += __shfl_xor(s, 16); s += __shfl_xor(s, 32);
                if (fq == 0) ssq[(size_t)r * 16 + u.pn * 4 + wc] = s; }
    }
};
struct EpiSwiGLU {
    static constexpr bool PERM = true, AFTER_DRAIN = false; static constexpr int LANE_T = 0; static constexpr bool ZFIRST = ZF_DEFAULT;
    bf16_t* O; int ldc; const float* ssq; float inv_d, eps;
    __device__ __forceinline__ void operator()(const f32x4 (&acc)[2][2][4][2], const Unit& u, int wr, int wc, int fr, int fq) const {
        const int col0 = u.pn * HALF + wc * 32 + 8 * fq;
#pragma unroll
        for (int ai = 0; ai < 2; ++ai)
#pragma unroll
            for (int m = 0; m < 4; ++m) { const int r = u.pm * BM + ai * HALF + wr * 64 + m * 16 + fr;
                const f32x4* sp = (const f32x4*)(ssq + (size_t)r * 16); const f32x4 a = sp[0], b = sp[1], c = sp[2], d = sp[3];
                const float ss = ((a[0] + a[1]) + (a[2] + a[3])) + ((b[0] + b[1]) + (b[2] + b[3])) + ((c[0] + c[1]) + (c[2] + c[3])) + ((d[0] + d[1]) + (d[2] + d[3]));
                const float rstd = 1.0f / sqrtf(ss * inv_d + eps);
                float v[8];
#pragma unroll
                for (int n = 0; n < 2; ++n)
#pragma unroll
                    for (int e = 0; e < 4; ++e) { const float g = acc[ai][0][m][n][e] * rstd, up = acc[ai][1][m][n][e] * rstd;
                        const float sg = g * __builtin_amdgcn_rcpf(1.0f + __builtin_amdgcn_exp2f(-1.4426950408889634f * g)); v[n * 4 + e] = sg * up; }
                u32x4 w; w.x = cvt_pk_bf16(v[0], v[1]); w.y = cvt_pk_bf16(v[2], v[3]); w.z = cvt_pk_bf16(v[4], v[5]); w.w = cvt_pk_bf16(v[6], v[7]);
                *(u32x4*)(O + (size_t)r * ldc + col0) = w; }
    }
};
struct EpiAccOut {
    static constexpr bool PERM = false, AFTER_DRAIN = false; static constexpr int LANE_T = 0; static constexpr bool ZFIRST = ZF_DEFAULT;
    float* out; int ldc;
    __device__ __forceinline__ void operator()(const f32x4 (&acc)[2][2][4][2], const Unit& u, int wr, int wc, int fr, int fq) const {
        const int col0 = u.pn * BM + wc * 32 + 4 * fq;
#pragma unroll
        for (int ai = 0; ai < 2; ++ai)
#pragma unroll
            for (int m = 0; m < 4; ++m) { float* rowp = out + (size_t)(u.pm * BM + ai * HALF + wr * 64 + m * 16 + fr) * ldc + col0;
#pragma unroll
                for (int bj = 0; bj < 2; ++bj)
#pragma unroll
                    for (int n = 0; n < 2; ++n) { const f32x4 bs = *(const f32x4*)(rowp + bj * HALF + n * 16); *(f32x4*)(rowp + bj * HALF + n * 16) = bs + acc[ai][bj][m][n]; } }
    }
};

struct EpiProj {
    static constexpr bool PERM = true, AFTER_DRAIN = false; static constexpr int LANE_T = 0; static constexpr bool ZFIRST = ZF_DEFAULT;
    bf16_t* O; int ldc; const float* rot;
    __device__ __forceinline__ void operator()(const f32x4 (&acc)[2][2][4][2], const Unit& u, int wr, int wc, int fr, int fq) const {
        const int row0 = u.pm * BM + wr * 64 + fr;
        if (u.pn < 4) {
            const float ksc = (u.pn >= 2) ? 0.125f : 1.0f; const int col_lo = u.pn * BM + wc * 64 + 8 * fq;
#pragma unroll
            for (int ai = 0; ai < 2; ++ai)
#pragma unroll
                for (int m = 0; m < 4; ++m) { const int r = row0 + ai * HALF + m * 16; const f32x4* rp = (const f32x4*)(rot + ((size_t)r * 32 + 8 * fq) * 2); bf16_t* rowp = O + (size_t)r * ldc + col_lo;
                    const f32x4 c0 = rp[0], c1 = rp[1], c2 = rp[2], c3 = rp[3];
                    const f32x4 a0 = acc[ai][0][m][0], a1 = acc[ai][0][m][1], b0 = acc[ai][1][m][0], b1 = acc[ai][1][m][1];
                    float lo[8], hi[8];
                    lo[0] = a0[0] * c0[0] - b0[0] * c0[1]; hi[0] = b0[0] * c0[0] + a0[0] * c0[1]; lo[1] = a0[1] * c0[2] - b0[1] * c0[3]; hi[1] = b0[1] * c0[2] + a0[1] * c0[3];
                    lo[2] = a0[2] * c1[0] - b0[2] * c1[1]; hi[2] = b0[2] * c1[0] + a0[2] * c1[1]; lo[3] = a0[3] * c1[2] - b0[3] * c1[3]; hi[3] = b0[3] * c1[2] + a0[3] * c1[3];
                    lo[4] = a1[0] * c2[0] - b1[0] * c2[1]; hi[4] = b1[0] * c2[0] + a1[0] * c2[1]; lo[5] = a1[1] * c2[2] - b1[1] * c2[3]; hi[5] = b1[1] * c2[2] + a1[1] * c2[3];
                    lo[6] = a1[2] * c3[0] - b1[2] * c3[1]; hi[6] = b1[2] * c3[0] + a1[2] * c3[1]; lo[7] = a1[3] * c3[2] - b1[3] * c3[3]; hi[7] = b1[3] * c3[2] + a1[3] * c3[3];
                    u32x4 w; w.x = cvt_pk_bf16(lo[0] * ksc, lo[1] * ksc); w.y = cvt_pk_bf16(lo[2] * ksc, lo[3] * ksc); w.z = cvt_pk_bf16(lo[4] * ksc, lo[5] * ksc); w.w = cvt_pk_bf16(lo[6] * ksc, lo[7] * ksc);
                    *(u32x4*)rowp = w;
                    w.x = cvt_pk_bf16(hi[0] * ksc, hi[1] * ksc); w.y = cvt_pk_bf16(hi[2] * ksc, hi[3] * ksc); w.z = cvt_pk_bf16(hi[4] * ksc, hi[5] * ksc); w.w = cvt_pk_bf16(hi[6] * ksc, hi[7] * ksc);
                    *(u32x4*)(rowp + 32) = w; }
        } else {
            const int col0 = u.pn * BM + wc * 32 + 8 * fq;
#pragma unroll
            for (int ai = 0; ai < 2; ++ai)
#pragma unroll
                for (int m = 0; m < 4; ++m) { bf16_t* rowp = O + (size_t)(row0 + ai * HALF + m * 16) * ldc + col0;
#pragma unroll
                    for (int bj = 0; bj < 2; ++bj) { const f32x4 v0 = acc[ai][bj][m][0], v1 = acc[ai][bj][m][1];
                        u32x4 w; w.x = cvt_pk_bf16(v0[0], v0[1]); w.y = cvt_pk_bf16(v0[2], v0[3]); w.z = cvt_pk_bf16(v1[0], v1[1]); w.w = cvt_pk_bf16(v1[2], v1[3]);
                        *(u32x4*)(rowp + bj * HALF) = w; } }
        }
    }
};

#define PG8_FENCE() asm volatile("" ::: "memory")
struct EpiResid2 {
    static constexpr bool PERM = false, AFTER_DRAIN = false; static constexpr int LANE_T = 0; static constexpr bool ZFIRST = ZF_DEFAULT;
    const float* base; bf16_t* xb; float* ssq; int ldc;
    __device__ __forceinline__ void operator()(const f32x4 (&acc)[2][2][4][2], const Unit& u, int wr, int wc, int fr, int fq) const {
        const int col0 = u.pn * BM + wc * 32 + 4 * fq; const int rowb = u.pm * BM + wr * 64 + fr;
        f32x4 b0[4], b1[4], b2[4];
#define PG8_R2_LOAD(B, g) do { const float* p_ = base + (size_t)(rowb + ((g) >> 2) * HALF + ((g) & 3) * 16) * ldc + col0; B[0] = *(const f32x4*)(p_); B[1] = *(const f32x4*)(p_ + 16); B[2] = *(const f32x4*)(p_ + HALF); B[3] = *(const f32x4*)(p_ + HALF + 16); } while (0)
#define PG8_R2_PROC(B, g) do { const int ai_ = (g) >> 2, m_ = (g) & 3; const int r_ = rowb + ai_ * HALF + m_ * 16; bf16_t* q_ = xb + (size_t)r_ * ldc + col0; float s_ = 0.f; \
            _Pragma("unroll") for (int bj = 0; bj < 2; ++bj) _Pragma("unroll") for (int n = 0; n < 2; ++n) { const f32x4 o = B[bj * 2 + n] + acc[ai_][bj][m_][n]; \
                u32x2 w; w.x = cvt_pk_bf16(o[0], o[1]); w.y = cvt_pk_bf16(o[2], o[3]); *(u32x2*)(q_ + bj * HALF + n * 16) = w; s_ += (o[0] * o[0] + o[1] * o[1]) + (o[2] * o[2] + o[3] * o[3]); } \
            s_ += __shfl_xor(s_, 16); s_ += __shfl_xor(s_, 32); if (fq == 0) ssq[(size_t)r_ * 16 + u.pn * 4 + wc] = s_; } while (0)
        PG8_R2_LOAD(b0, 0); PG8_R2_LOAD(b1, 1); PG8_FENCE();
        PG8_R2_LOAD(b2, 2); PG8_FENCE(); PG8_R2_PROC(b0, 0); PG8_FENCE();
        PG8_R2_LOAD(b0, 3); PG8_FENCE(); PG8_R2_PROC(b1, 1); PG8_FENCE();
        PG8_R2_LOAD(b1, 4); PG8_FENCE(); PG8_R2_PROC(b2, 2); PG8_FENCE();
        PG8_R2_LOAD(b2, 5); PG8_FENCE(); PG8_R2_PROC(b0, 3); PG8_FENCE();
        PG8_R2_LOAD(b0, 6); PG8_FENCE(); PG8_R2_PROC(b1, 4); PG8_FENCE();
        PG8_R2_LOAD(b1, 7); PG8_FENCE(); PG8_R2_PROC(b2, 5); PG8_FENCE();
        PG8_R2_PROC(b0, 6); PG8_FENCE(); PG8_R2_PROC(b1, 7);
#undef PG8_R2_LOAD
#undef PG8_R2_PROC
    }
};
struct EpiSwiGLU2 {
    static constexpr bool PERM = true, AFTER_DRAIN = false; static constexpr int LANE_T = 0; static constexpr bool ZFIRST = ZF_DEFAULT;
    bf16_t* O; int ldc; const float* rstd;
    __device__ __forceinline__ void operator()(const f32x4 (&acc)[2][2][4][2], const Unit& u, int wr, int wc, int fr, int fq) const {
        const int col0 = u.pn * HALF + wc * 32 + 8 * fq; const int rowb = u.pm * BM + wr * 64 + fr;
        float rs[8];
#pragma unroll
        for (int g = 0; g < 8; ++g) rs[g] = rstd[rowb + (g >> 2) * HALF + (g & 3) * 16];
        PG8_FENCE();
#pragma unroll
        for (int g = 0; g < 8; ++g) { const int ai = g >> 2, m = g & 3; const float r_ = rs[g], c1 = -1.4426950408889634f * r_, r2 = r_ * r_; float v[8];
#pragma unroll
            for (int n = 0; n < 2; ++n)
#pragma unroll
                for (int e = 0; e < 4; ++e) { const float gt = acc[ai][0][m][n][e], up = acc[ai][1][m][n][e];
                    v[n * 4 + e] = (gt * up) * (r2 * __builtin_amdgcn_rcpf(1.0f + __builtin_amdgcn_exp2f(gt * c1))); }
            u32x4 w; w.x = cvt_pk_bf16(v[0], v[1]); w.y = cvt_pk_bf16(v[2], v[3]); w.z = cvt_pk_bf16(v[4], v[5]); w.w = cvt_pk_bf16(v[6], v[7]);
            *(u32x4*)(O + (size_t)(rowb + ai * HALF + m * 16) * ldc + col0) = w; }
    }
};
struct EpiOut2 {
    static constexpr bool PERM = false, AFTER_DRAIN = false; static constexpr int LANE_T = 0; static constexpr bool ZFIRST = ZF_DEFAULT;
    const bf16_t* xb; float* out; int ldc;
    __device__ __forceinline__ void operator()(const f32x4 (&acc)[2][2][4][2], const Unit& u, int wr, int wc, int fr, int fq) const {
        const int col0 = u.pn * BM + wc * 32 + 4 * fq; const int rowb = u.pm * BM + wr * 64 + fr;
        u32x2 xr[8][4];
#pragma unroll
        for (int g = 0; g < 8; ++g) { const bf16_t* p_ = xb + (size_t)(rowb + (g >> 2) * HALF + (g & 3) * 16) * ldc + col0;
            xr[g][0] = *(const u32x2*)(p_); xr[g][1] = *(const u32x2*)(p_ + 16); xr[g][2] = *(const u32x2*)(p_ + HALF); xr[g][3] = *(const u32x2*)(p_ + HALF + 16); }
        PG8_FENCE();
#pragma unroll
        for (int g = 0; g < 8; ++g) { const int ai = g >> 2, m = g & 3; float* q_ = out + (size_t)(rowb + ai * HALF + m * 16) * ldc + col0;
#pragma unroll
            for (int bj = 0; bj < 2; ++bj)
#pragma unroll
                for (int n = 0; n < 2; ++n) { const u32x2 w = xr[g][bj * 2 + n]; f32x4 b;
                    b[0] = __builtin_bit_cast(float, w.x << 16); b[1] = __builtin_bit_cast(float, w.x & 0xffff0000u); b[2] = __builtin_bit_cast(float, w.y << 16); b[3] = __builtin_bit_cast(float, w.y & 0xffff0000u);
                    *(f32x4*)(q_ + bj * HALF + n * 16) = b + acc[ai][bj][m][n]; } }
    }
};
struct EpiProj2 {
    static constexpr bool PERM = true, AFTER_DRAIN = false; static constexpr int LANE_T = 0; static constexpr bool ZFIRST = ZF_DEFAULT;
    bf16_t* O; int ldc; const float* rot;
    __device__ __forceinline__ void operator()(const f32x4 (&acc)[2][2][4][2], const Unit& u, int wr, int wc, int fr, int fq) const {
        const int row0 = u.pm * BM + wr * 64 + fr;
        if (u.pn < 4) {
            const float ksc = (u.pn >= 2) ? 0.125f : 1.0f; const int col_lo = u.pn * BM + wc * 64 + 8 * fq;
            f32x4 c0_[4], c1_[4], c2_[4];
#define PG8_P2_LOAD(C, g) do { const f32x4* rp_ = (const f32x4*)(rot + ((size_t)(row0 + ((g) >> 2) * HALF + ((g) & 3) * 16) * 32 + 8 * fq) * 2); C[0] = rp_[0]; C[1] = rp_[1]; C[2] = rp_[2]; C[3] = rp_[3]; } while (0)
#define PG8_P2_PROC(C, g) do { const int ai_ = (g) >> 2, m_ = (g) & 3; bf16_t* rowp = O + (size_t)(row0 + ai_ * HALF + m_ * 16) * ldc + col_lo; \
                const f32x4 a0 = acc[ai_][0][m_][0], a1 = acc[ai_][0][m_][1], b0 = acc[ai_][1][m_][0], b1 = acc[ai_][1][m_][1]; float lo[8], hi[8]; \
                lo[0] = a0[0] * C[0][0] - b0[0] * C[0][1]; hi[0] = b0[0] * C[0][0] + a0[0] * C[0][1]; lo[1] = a0[1] * C[0][2] - b0[1] * C[0][3]; hi[1] = b0[1] * C[0][2] + a0[1] * C[0][3]; \
                lo[2] = a0[2] * C[1][0] - b0[2] * C[1][1]; hi[2] = b0[2] * C[1][0] + a0[2] * C[1][1]; lo[3] = a0[3] * C[1][2] - b0[3] * C[1][3]; hi[3] = b0[3] * C[1][2] + a0[3] * C[1][3]; \
                lo[4] = a1[0] * C[2][0] - b1[0] * C[2][1]; hi[4] = b1[0] * C[2][0] + a1[0] * C[2][1]; lo[5] = a1[1] * C[2][2] - b1[1] * C[2][3]; hi[5] = b1[1] * C[2][2] + a1[1] * C[2][3]; \
                lo[6] = a1[2] * C[3][0] - b1[2] * C[3][1]; hi[6] = b1[2] * C[3][0] + a1[2] * C[3][1]; lo[7] = a1[3] * C[3][2] - b1[3] * C[3][3]; hi[7] = b1[3] * C[3][2] + a1[3] * C[3][3]; \
                u32x4 w; w.x = cvt_pk_bf16(lo[0] * ksc, lo[1] * ksc); w.y = cvt_pk_bf16(lo[2] * ksc, lo[3] * ksc); w.z = cvt_pk_bf16(lo[4] * ksc, lo[5] * ksc); w.w = cvt_pk_bf16(lo[6] * ksc, lo[7] * ksc); \
                *(u32x4*)rowp = w; \
                w.x = cvt_pk_bf16(hi[0] * ksc, hi[1] * ksc); w.y = cvt_pk_bf16(hi[2] * ksc, hi[3] * ksc); w.z = cvt_pk_bf16(hi[4] * ksc, hi[5] * ksc); w.w = cvt_pk_bf16(hi[6] * ksc, hi[7] * ksc); \
                *(u32x4*)(rowp + 32) = w; } while (0)
            PG8_P2_LOAD(c0_, 0); PG8_P2_LOAD(c1_, 1); PG8_FENCE();
            PG8_P2_LOAD(c2_, 2); PG8_FENCE(); PG8_P2_PROC(c0_, 0); PG8_FENCE();
            PG8_P2_LOAD(c0_, 3); PG8_FENCE(); PG8_P2_PROC(c1_, 1); PG8_FENCE();
            PG8_P2_LOAD(c1_, 4); PG8_FENCE(); PG8_P2_PROC(c2_, 2); PG8_FENCE();
            PG8_P2_LOAD(c2_, 5); PG8_FENCE(); PG8_P2_PROC(c0_, 3); PG8_FENCE();
            PG8_P2_LOAD(c0_, 6); PG8_FENCE(); PG8_P2_PROC(c1_, 4); PG8_FENCE();
            PG8_P2_LOAD(c1_, 7); PG8_FENCE(); PG8_P2_PROC(c2_, 5); PG8_FENCE();
            PG8_P2_PROC(c0_, 6); PG8_FENCE(); PG8_P2_PROC(c1_, 7);
#undef PG8_P2_LOAD
#undef PG8_P2_PROC
        } else {
            const int col0 = u.pn * BM + wc * 32 + 8 * fq;
#pragma unroll
            for (int ai = 0; ai < 2; ++ai)
#pragma unroll
                for (int m = 0; m < 4; ++m) { bf16_t* rowp = O + (size_t)(row0 + ai * HALF + m * 16) * ldc + col0;
#pragma unroll
                    for (int bj = 0; bj < 2; ++bj) { const f32x4 v0 = acc[ai][bj][m][0], v1 = acc[ai][bj][m][1];
                        u32x4 w; w.x = cvt_pk_bf16(v0[0], v0[1]); w.y = cvt_pk_bf16(v0[2], v0[3]); w.z = cvt_pk_bf16(v1[0], v1[1]); w.w = cvt_pk_bf16(v1[2], v1[3]);
                        *(u32x4*)(rowp + bj * HALF) = w; } }
        }
    }
};

__device__ __forceinline__ float oct_sum(float v) {
    v += __int_as_float(__builtin_amdgcn_update_dpp(0, __float_as_int(v), 0xB1, 0xf, 0xf, false));
    v += __int_as_float(__builtin_amdgcn_update_dpp(0, __float_as_int(v), 0x4E, 0xf, 0xf, false));
    v += __int_as_float(__builtin_amdgcn_update_dpp(0, __float_as_int(v), 0x141, 0xf, 0xf, false));
    return v;
}
struct EpiOut5 {
    static constexpr bool PERM = false, AFTER_DRAIN = false; static constexpr int LANE_T = 2; static constexpr bool ZFIRST = ZF_DEFAULT;
    const bf16_t* xb; float* out; int ldc;
    __device__ __forceinline__ void operator()(const f32x4 (&acc)[2][2][4][2], const Unit& u, int wr, int wc, int rr, int c) const {
        const int col0 = u.pn * BM + wc * 32 + 4 * c; const int rowb = u.pm * BM + wr * 64 + rr;
        u32x2 xr[8][4];
#pragma unroll
        for (int g = 0; g < 8; ++g) { const bf16_t* p_ = xb + (size_t)(rowb + (g >> 2) * HALF + (g & 3) * 16) * ldc + col0;
            xr[g][0] = *(const u32x2*)(p_); xr[g][1] = *(const u32x2*)(p_ + 8 * (size_t)ldc); xr[g][2] = *(const u32x2*)(p_ + HALF); xr[g][3] = *(const u32x2*)(p_ + 8 * (size_t)ldc + HALF); }
        PG8_FENCE();
#pragma unroll
        for (int g = 0; g < 8; ++g) { const int ai = g >> 2, m = g & 3; float* q_ = out + (size_t)(rowb + ai * HALF + m * 16) * ldc + col0;
#pragma unroll
            for (int bj = 0; bj < 2; ++bj)
#pragma unroll
                for (int I = 0; I < 2; ++I) { const u32x2 w = xr[g][bj * 2 + I]; f32x4 b;
                    b[0] = __builtin_bit_cast(float, w.x << 16); b[1] = __builtin_bit_cast(float, w.x & 0xffff0000u); b[2] = __builtin_bit_cast(float, w.y << 16); b[3] = __builtin_bit_cast(float, w.y & 0xffff0000u);
                    *(f32x4*)(q_ + (size_t)(8 * I) * ldc + bj * HALF) = b + acc[ai][bj][m][I]; } }
    }
};
struct EpiResid5 {
    static constexpr bool PERM = false, AFTER_DRAIN = false; static constexpr int LANE_T = 2; static constexpr bool ZFIRST = ZF_DEFAULT;
    const float* base; bf16_t* xb; float* ssq; int ldc;
    __device__ __forceinline__ void operator()(const f32x4 (&acc)[2][2][4][2], const Unit& u, int wr, int wc, int rr, int c) const {
        const int col0 = u.pn * BM + wc * 32 + 4 * c; const int rowb = u.pm * BM + wr * 64 + rr;
        f32x4 b0[4], b1[4], b2[4];
#define PG8_R5_LOAD(B, g) do { const float* p_ = base + (size_t)(rowb + ((g) >> 2) * HALF + ((g) & 3) * 16) * ldc + col0; B[0] = *(const f32x4*)(p_); B[1] = *(const f32x4*)(p_ + 8 * (size_t)ldc); B[2] = *(const f32x4*)(p_ + HALF); B[3] = *(const f32x4*)(p_ + 8 * (size_t)ldc + HALF); } while (0)
#define PG8_R5_PROC(B, g) do { const int ai_ = (g) >> 2, m_ = (g) & 3; const int r_ = rowb + ai_ * HALF + m_ * 16; bf16_t* q_ = xb + (size_t)r_ * ldc + col0; \
            _Pragma("unroll") for (int I = 0; I < 2; ++I) { float s_ = 0.f; \
                _Pragma("unroll") for (int bj = 0; bj < 2; ++bj) { const f32x4 o = B[bj * 2 + I] + acc[ai_][bj][m_][I]; \
                    u32x2 w; w.x = cvt_pk_bf16(o[0], o[1]); w.y = cvt_pk_bf16(o[2], o[3]); *(u32x2*)(q_ + (size_t)(8 * I) * ldc + bj * HALF) = w; s_ += (o[0] * o[0] + o[1] * o[1]) + (o[2] * o[2] + o[3] * o[3]); } \
                s_ = oct_sum(s_); if (c == 0) ssq[(size_t)(r_ + 8 * I) * 16 + u.pn * 4 + wc] = s_; } } while (0)
        PG8_R5_LOAD(b0, 0); PG8_R5_LOAD(b1, 1); PG8_FENCE();
        PG8_R5_LOAD(b2, 2); PG8_FENCE(); PG8_R5_PROC(b0, 0); PG8_FENCE();
        PG8_R5_LOAD(b0, 3); PG8_FENCE(); PG8_R5_PROC(b1, 1); PG8_FENCE();
        PG8_R5_LOAD(b1, 4); PG8_FENCE(); PG8_R5_PROC(b2, 2); PG8_FENCE();
        PG8_R5_LOAD(b2, 5); PG8_FENCE(); PG8_R5_PROC(b0, 3); PG8_FENCE();
        PG8_R5_LOAD(b0, 6); PG8_FENCE(); PG8_R5_PROC(b1, 4); PG8_FENCE();
        PG8_R5_LOAD(b1, 7); PG8_FENCE(); PG8_R5_PROC(b2, 5); PG8_FENCE();
        PG8_R5_PROC(b0, 6); PG8_FENCE(); PG8_R5_PROC(b1, 7);
#undef PG8_R5_LOAD
#undef PG8_R5_PROC
    }
};

struct EpiProj3 {
    static constexpr bool PERM = true, AFTER_DRAIN = false; static constexpr int LANE_T = 0; static constexpr bool ZFIRST = ZF_DEFAULT;
    bf16_t* O; int ldc; const int* pos;
    __device__ __forceinline__ void operator()(const f32x4 (&acc)[2][2][4][2], const Unit& u, int wr, int wc, int fr, int fq) const {
        const int row0 = u.pm * BM + wr * 64 + fr;
        if (u.pn < 4) {
            const float ksc = (u.pn >= 2) ? 0.125f : 1.0f; const int col_lo = u.pn * BM + wc * 64 + 8 * fq;
            f32x4 c0_[4], c1_[4], c2_[4];
            float inv[8]; int pp[8];
#pragma unroll
            for (int jj = 0; jj < 8; ++jj) inv[jj] = __builtin_amdgcn_exp2f(-(float)(8 * fq + jj) * (13.287712379549449f / 32.0f));
#pragma unroll
            for (int g = 0; g < 8; ++g) pp[g] = pos[row0 + (g >> 2) * HALF + (g & 3) * 16];
            PG8_FENCE();
#define PG8_P2_LOAD(C, g) do { const float p_ = (float)pp[g]; _Pragma("unroll") for (int jj = 0; jj < 8; ++jj) { const float ang_ = p_ * inv[jj]; const float rev_ = ang_ * 0.15915494f; \
                const float x_ = __builtin_amdgcn_fractf(rev_) + (__builtin_fmaf(ang_, 0.15915494f, -rev_) + ang_ * 6.4206383e-9f);     \
                C[jj >> 1][(jj & 1) * 2] = __builtin_amdgcn_cosf(x_); C[jj >> 1][(jj & 1) * 2 + 1] = __builtin_amdgcn_sinf(x_); } } while (0)
#define PG8_P2_PROC(C, g) do { const int ai_ = (g) >> 2, m_ = (g) & 3; bf16_t* rowp = O + (size_t)(row0 + ai_ * HALF + m_ * 16) * ldc + col_lo; \
                const f32x4 a0 = acc[ai_][0][m_][0], a1 = acc[ai_][0][m_][1], b0 = acc[ai_][1][m_][0], b1 = acc[ai_][1][m_][1]; float lo[8], hi[8]; \
                lo[0] = a0[0] * C[0][0] - b0[0] * C[0][1]; hi[0] = b0[0] * C[0][0] + a0[0] * C[0][1]; lo[1] = a0[1] * C[0][2] - b0[1] * C[0][3]; hi[1] = b0[1] * C[0][2] + a0[1] * C[0][3]; \
                lo[2] = a0[2] * C[1][0] - b0[2] * C[1][1]; hi[2] = b0[2] * C[1][0] + a0[2] * C[1][1]; lo[3] = a0[3] * C[1][2] - b0[3] * C[1][3]; hi[3] = b0[3] * C[1][2] + a0[3] * C[1][3]; \
                lo[4] = a1[0] * C[2][0] - b1[0] * C[2][1]; hi[4] = b1[0] * C[2][0] + a1[0] * C[2][1]; lo[5] = a1[1] * C[2][2] - b1[1] * C[2][3]; hi[5] = b1[1] * C[2][2] + a1[1] * C[2][3]; \
                lo[6] = a1[2] * C[3][0] - b1[2] * C[3][1]; hi[6] = b1[2] * C[3][0] + a1[2] * C[3][1]; lo[7] = a1[3] * C[3][2] - b1[3] * C[3][3]; hi[7] = b1[3] * C[3][2] + a1[3] * C[3][3]; \
                u32x4 w; w.x = cvt_pk_bf16(lo[0] * ksc, lo[1] * ksc); w.y = cvt_pk_bf16(lo[2] * ksc, lo[3] * ksc); w.z = cvt_pk_bf16(lo[4] * ksc, lo[5] * ksc); w.w = cvt_pk_bf16(lo[6] * ksc, lo[7] * ksc); \
                *(u32x4*)rowp = w; \
                w.x = cvt_pk_bf16(hi[0] * ksc, hi[1] * ksc); w.y = cvt_pk_bf16(hi[2] * ksc, hi[3] * ksc); w.z = cvt_pk_bf16(hi[4] * ksc, hi[5] * ksc); w.w = cvt_pk_bf16(hi[6] * ksc, hi[7] * ksc); \
                *(u32x4*)(rowp + 32) = w; } while (0)
            PG8_P2_LOAD(c0_, 0); PG8_P2_LOAD(c1_, 1); PG8_FENCE();
            PG8_P2_LOAD(c2_, 2); PG8_FENCE(); PG8_P2_PROC(c0_, 0); PG8_FENCE();
            PG8_P2_LOAD(c0_, 3); PG8_FENCE(); PG8_P2_PROC(c1_, 1); PG8_FENCE();
            PG8_P2_LOAD(c1_, 4); PG8_FENCE(); PG8_P2_PROC(c2_, 2); PG8_FENCE();
            PG8_P2_LOAD(c2_, 5); PG8_FENCE(); PG8_P2_PROC(c0_, 3); PG8_FENCE();
            PG8_P2_LOAD(c0_, 6); PG8_FENCE(); PG8_P2_PROC(c1_, 4); PG8_FENCE();
            PG8_P2_LOAD(c1_, 7); PG8_FENCE(); PG8_P2_PROC(c2_, 5); PG8_FENCE();
            PG8_P2_PROC(c0_, 6); PG8_FENCE(); PG8_P2_PROC(c1_, 7);
#undef PG8_P2_LOAD
#undef PG8_P2_PROC
        } else {
            const int col0 = u.pn * BM + wc * 32 + 8 * fq;
#pragma unroll
            for (int ai = 0; ai < 2; ++ai)
#pragma unroll
                for (int m = 0; m < 4; ++m) { bf16_t* rowp = O + (size_t)(row0 + ai * HALF + m * 16) * ldc + col0;
#pragma unroll
                    for (int bj = 0; bj < 2; ++bj) { const f32x4 v0 = acc[ai][bj][m][0], v1 = acc[ai][bj][m][1];
                        u32x4 w; w.x = cvt_pk_bf16(v0[0], v0[1]); w.y = cvt_pk_bf16(v0[2], v0[3]); w.z = cvt_pk_bf16(v1[0], v1[1]); w.w = cvt_pk_bf16(v1[2], v1[3]);
                        *(u32x4*)(rowp + bj * HALF) = w; } }
        }
    }
};

__device__ __forceinline__ void lane_exchange(f32x4 (&acc)[2][2][4][2], int lane) {
    const bool hi_ = (lane & 8) != 0; const int rr_ = lane >> 3, c_ = lane & 7; const int pa = (rr_ + 8 * (c_ >> 2) + 16 * (c_ & 3)) << 2;
#pragma unroll
    for (int a = 0; a < 2; ++a)
#pragma unroll
        for (int b = 0; b < 2; ++b)
#pragma unroll
            for (int m = 0; m < 4; ++m)
#pragma unroll
                for (int e = 0; e < 4; ++e) { const float a0 = acc[a][b][m][0][e], a1 = acc[a][b][m][1][e]; const float snd = hi_ ? a0 : a1;
                    const float rcv = __int_as_float(__builtin_amdgcn_update_dpp(0, __float_as_int(snd), 0x128, 0xf, 0xf, false));
                    const float d0 = hi_ ? rcv : a0, d1 = hi_ ? a1 : rcv;
                    acc[a][b][m][0][e] = __int_as_float(__builtin_amdgcn_ds_bpermute(pa, __float_as_int(d0))); acc[a][b][m][1][e] = __int_as_float(__builtin_amdgcn_ds_bpermute(pa, __float_as_int(d1))); }
}
struct EpiOut6 {
    static constexpr bool PERM = false, AFTER_DRAIN = false; static constexpr int LANE_T = 3; static constexpr bool ZFIRST = ZF_DEFAULT;
    const bf16_t* xb; float* out; int ldc;
    __device__ __forceinline__ void run(f32x4 (&acc)[2][2][4][2], const Unit& u, int wr, int wc, int lane) const {
        const int rr = lane >> 3, c = lane & 7;
        const int col0 = u.pn * BM + wc * 32 + 4 * c; const int rowb = u.pm * BM + wr * 64 + rr;
        u32x2 xr[8][4];
#pragma unroll
        for (int g = 0; g < 8; ++g) { const bf16_t* p_ = xb + (size_t)(rowb + (g >> 2) * HALF + (g & 3) * 16) * ldc + col0;
            xr[g][0] = *(const u32x2*)(p_); xr[g][1] = *(const u32x2*)(p_ + 8 * (size_t)ldc); xr[g][2] = *(const u32x2*)(p_ + HALF); xr[g][3] = *(const u32x2*)(p_ + 8 * (size_t)ldc + HALF); }
        PG8_FENCE();
        lane_exchange(acc, lane);
        PG8_FENCE();
#pragma unroll
        for (int g = 0; g < 8; ++g) { const int ai = g >> 2, m = g & 3; float* q_ = out + (size_t)(rowb + ai * HALF + m * 16) * ldc + col0;
#pragma unroll
            for (int bj = 0; bj < 2; ++bj)
#pragma unroll
                for (int I = 0; I < 2; ++I) { const u32x2 w = xr[g][bj * 2 + I]; f32x4 b;
                    b[0] = __builtin_bit_cast(float, w.x << 16); b[1] = __builtin_bit_cast(float, w.x & 0xffff0000u); b[2] = __builtin_bit_cast(float, w.y << 16); b[3] = __builtin_bit_cast(float, w.y & 0xffff0000u);
                    *(f32x4*)(q_ + (size_t)(8 * I) * ldc + bj * HALF) = b + acc[ai][bj][m][I]; } }
    }
};
struct EpiResid6 {
    static constexpr bool PERM = false, AFTER_DRAIN = false; static constexpr int LANE_T = 3; static constexpr bool ZFIRST = ZF_DEFAULT;
    const float* base; bf16_t* xb; float* ssq; int ldc;
    __device__ __forceinline__ void run(f32x4 (&acc)[2][2][4][2], const Unit& u, int wr, int wc, int lane) const {
        const int rr = lane >> 3, c = lane & 7;
        const int col0 = u.pn * BM + wc * 32 + 4 * c; const int rowb = u.pm * BM + wr * 64 + rr;
        f32x4 b0[4], b1[4], b2[4];
#define PG8_R5_LOAD(B, g) do { const float* p_ = base + (size_t)(rowb + ((g) >> 2) * HALF + ((g) & 3) * 16) * ldc + col0; B[0] = *(const f32x4*)(p_); B[1] = *(const f32x4*)(p_ + 8 * (size_t)ldc); B[2] = *(const f32x4*)(p_ + HALF); B[3] = *(const f32x4*)(p_ + 8 * (size_t)ldc + HALF); } while (0)
#define PG8_R5_PROC(B, g) do { const int ai_ = (g) >> 2, m_ = (g) & 3; const int r_ = rowb + ai_ * HALF + m_ * 16; bf16_t* q_ = xb + (size_t)r_ * ldc + col0; \
            _Pragma("unroll") for (int I = 0; I < 2; ++I) { float s_ = 0.f; \
                _Pragma("unroll") for (int bj = 0; bj < 2; ++bj) { const f32x4 o = B[bj * 2 + I] + acc[ai_][bj][m_][I]; \
                    u32x2 w; w.x = cvt_pk_bf16(o[0], o[1]); w.y = cvt_pk_bf16(o[2], o[3]); *(u32x2*)(q_ + (size_t)(8 * I) * ldc + bj * HALF) = w; s_ += (o[0] * o[0] + o[1] * o[1]) + (o[2] * o[2] + o[3] * o[3]); } \
                s_ = oct_sum(s_); if (c == 0) ssq[(size_t)(r_ + 8 * I) * 16 + u.pn * 4 + wc] = s_; } } while (0)
        PG8_R5_LOAD(b0, 0); PG8_R5_LOAD(b1, 1); PG8_FENCE();
        lane_exchange(acc, lane);
        PG8_FENCE(); PG8_R5_LOAD(b2, 2); PG8_FENCE(); PG8_R5_PROC(b0, 0); PG8_FENCE();
        PG8_R5_LOAD(b0, 3); PG8_FENCE(); PG8_R5_PROC(b1, 1); PG8_FENCE();
        PG8_R5_LOAD(b1, 4); PG8_FENCE(); PG8_R5_PROC(b2, 2); PG8_FENCE();
        PG8_R5_LOAD(b2, 5); PG8_FENCE(); PG8_R5_PROC(b0, 3); PG8_FENCE();
        PG8_R5_LOAD(b0, 6); PG8_FENCE(); PG8_R5_PROC(b1, 4); PG8_FENCE();
        PG8_R5_LOAD(b1, 7); PG8_FENCE(); PG8_R5_PROC(b2, 5); PG8_FENCE();
        PG8_R5_PROC(b0, 6); PG8_FENCE(); PG8_R5_PROC(b1, 7);
#undef PG8_R5_LOAD
#undef PG8_R5_PROC
    }
};

struct EpiSwiGLU2N {
    static constexpr bool PERM = true, AFTER_DRAIN = false; static constexpr int LANE_T = 0; static constexpr bool ZFIRST = ZF_DEFAULT;
    bf16_t* O; int ldc; const float* rstd;
    __device__ __forceinline__ void operator()(const f32x4 (&acc)[2][2][4][2], const Unit& u, int wr, int wc, int fr, int fq) const {
        const int col0 = u.pn * HALF + wc * 32 + 8 * fq; const int rowb = u.pm * BM + wr * 64 + fr;
        float rs[8];
#pragma unroll
        for (int g = 0; g < 8; ++g) rs[g] = rstd[rowb + (g >> 2) * HALF + (g & 3) * 16];
        PG8_FENCE();
#pragma unroll
        for (int g = 0; g < 8; ++g) { const int ai = g >> 2, m = g & 3; const float r_ = rs[g], c1 = -1.4426950408889634f * r_, r2 = r_ * r_; float v[8];
#pragma unroll
            for (int n = 0; n < 2; ++n)
#pragma unroll
                for (int e = 0; e < 4; ++e) { const float gt = acc[ai][0][m][n][e], up = acc[ai][1][m][n][e];
                    v[n * 4 + e] = (gt * up) * (r2 * __builtin_amdgcn_rcpf(1.0f + __builtin_amdgcn_exp2f(gt * c1))); }
            u32x4 w; w.x = cvt_pk_bf16(v[0], v[1]); w.y = cvt_pk_bf16(v[2], v[3]); w.z = cvt_pk_bf16(v[4], v[5]); w.w = cvt_pk_bf16(v[6], v[7]);
            __builtin_nontemporal_store(w, (u32x4*)(O + (size_t)(rowb + ai * HALF + m * 16) * ldc + col0)); }
    }
};
struct EpiProj3N {
    static constexpr bool PERM = true, AFTER_DRAIN = false; static constexpr int LANE_T = 0; static constexpr bool ZFIRST = ZF_DEFAULT;
    bf16_t* O; int ldc; const int* pos;
    __device__ __forceinline__ void operator()(const f32x4 (&acc)[2][2][4][2], const Unit& u, int wr, int wc, int fr, int fq) const {
        const int row0 = u.pm * BM + wr * 64 + fr;
        if (u.pn < 4) {
            const float ksc = (u.pn >= 2) ? 0.125f : 1.0f; const int col_lo = u.pn * BM + wc * 64 + 8 * fq;
            f32x4 c0_[4], c1_[4], c2_[4];
            float inv[8]; int pp[8];
#pragma unroll
            for (int jj = 0; jj < 8; ++jj) inv[jj] = __builtin_amdgcn_exp2f(-(float)(8 * fq + jj) * (13.287712379549449f / 32.0f));
#pragma unroll
            for (int g = 0; g < 8; ++g) pp[g] = pos[row0 + (g >> 2) * HALF + (g & 3) * 16];
            PG8_FENCE();
#define PG8_P2_LOAD(C, g) do { const float p_ = (float)pp[g]; _Pragma("unroll") for (int jj = 0; jj < 8; ++jj) { const float ang_ = p_ * inv[jj]; const float rev_ = ang_ * 0.15915494f; \
                const float x_ = __builtin_amdgcn_fractf(rev_) + (__builtin_fmaf(ang_, 0.15915494f, -rev_) + ang_ * 6.4206383e-9f);     \
                C[jj >> 1][(jj & 1) * 2] = __builtin_amdgcn_cosf(x_); C[jj >> 1][(jj & 1) * 2 + 1] = __builtin_amdgcn_sinf(x_); } } while (0)
#define PG8_P2_PROC(C, g) do { const int ai_ = (g) >> 2, m_ = (g) & 3; bf16_t* rowp = O + (size_t)(row0 + ai_ * HALF + m_ * 16) * ldc + col_lo; \
                const f32x4 a0 = acc[ai_][0][m_][0], a1 = acc[ai_][0][m_][1], b0 = acc[ai_][1][m_][0], b1 = acc[ai_][1][m_][1]; float lo[8], hi[8]; \
                lo[0] = a0[0] * C[0][0] - b0[0] * C[0][1]; hi[0] = b0[0] * C[0][0] + a0[0] * C[0][1]; lo[1] = a0[1] * C[0][2] - b0[1] * C[0][3]; hi[1] = b0[1] * C[0][2] + a0[1] * C[0][3]; \
                lo[2] = a0[2] * C[1][0] - b0[2] * C[1][1]; hi[2] = b0[2] * C[1][0] + a0[2] * C[1][1]; lo[3] = a0[3] * C[1][2] - b0[3] * C[1][3]; hi[3] = b0[3] * C[1][2] + a0[3] * C[1][3]; \
                lo[4] = a1[0] * C[2][0] - b1[0] * C[2][1]; hi[4] = b1[0] * C[2][0] + a1[0] * C[2][1]; lo[5] = a1[1] * C[2][2] - b1[1] * C[2][3]; hi[5] = b1[1] * C[2][2] + a1[1] * C[2][3]; \
                lo[6] = a1[2] * C[3][0] - b1[2] * C[3][1]; hi[6] = b1[2] * C[3][0] + a1[2] * C[3][1]; lo[7] = a1[3] * C[3][2] - b1[3] * C[3][3]; hi[7] = b1[3] * C[3][2] + a1[3] * C[3][3]; \
                u32x4 w; w.x = cvt_pk_bf16(lo[0] * ksc, lo[1] * ksc); w.y = cvt_pk_bf16(lo[2] * ksc, lo[3] * ksc); w.z = cvt_pk_bf16(lo[4] * ksc, lo[5] * ksc); w.w = cvt_pk_bf16(lo[6] * ksc, lo[7] * ksc); \
                __builtin_nontemporal_store(w, (u32x4*)rowp); \
                w.x = cvt_pk_bf16(hi[0] * ksc, hi[1] * ksc); w.y = cvt_pk_bf16(hi[2] * ksc, hi[3] * ksc); w.z = cvt_pk_bf16(hi[4] * ksc, hi[5] * ksc); w.w = cvt_pk_bf16(hi[6] * ksc, hi[7] * ksc); \
                __builtin_nontemporal_store(w, (u32x4*)(rowp + 32)); } while (0)
            PG8_P2_LOAD(c0_, 0); PG8_P2_LOAD(c1_, 1); PG8_FENCE();
            PG8_P2_LOAD(c2_, 2); PG8_FENCE(); PG8_P2_PROC(c0_, 0); PG8_FENCE();
            PG8_P2_LOAD(c0_, 3); PG8_FENCE(); PG8_P2_PROC(c1_, 1); PG8_FENCE();
            PG8_P2_LOAD(c1_, 4); PG8_FENCE(); PG8_P2_PROC(c2_, 2); PG8_FENCE();
            PG8_P2_LOAD(c2_, 5); PG8_FENCE(); PG8_P2_PROC(c0_, 3); PG8_FENCE();
            PG8_P2_LOAD(c0_, 6); PG8_FENCE(); PG8_P2_PROC(c1_, 4); PG8_FENCE();
            PG8_P2_LOAD(c1_, 7); PG8_FENCE(); PG8_P2_PROC(c2_, 5); PG8_FENCE();
            PG8_P2_PROC(c0_, 6); PG8_FENCE(); PG8_P2_PROC(c1_, 7);
#undef PG8_P2_LOAD
#undef PG8_P2_PROC
        } else {
            const int col0 = u.pn * BM + wc * 32 + 8 * fq;
#pragma unroll
            for (int ai = 0; ai < 2; ++ai)
#pragma unroll
                for (int m = 0; m < 4; ++m) { bf16_t* rowp = O + (size_t)(row0 + ai * HALF + m * 16) * ldc + col0;
#pragma unroll
                    for (int bj = 0; bj < 2; ++bj) { const f32x4 v0 = acc[ai][bj][m][0], v1 = acc[ai][bj][m][1];
                        u32x4 w; w.x = cvt_pk_bf16(v0[0], v0[1]); w.y = cvt_pk_bf16(v0[2], v0[3]); w.z = cvt_pk_bf16(v1[0], v1[1]); w.w = cvt_pk_bf16(v1[2], v1[3]);
                        __builtin_nontemporal_store(w, (u32x4*)(rowp + bj * HALF)); } }
        }
    }
};

struct EpiOut6N {
    static constexpr bool PERM = false, AFTER_DRAIN = false; static constexpr int LANE_T = 3; static constexpr bool ZFIRST = ZF_DEFAULT;
    const bf16_t* xb; float* out; int ldc;
    __device__ __forceinline__ void run(f32x4 (&acc)[2][2][4][2], const Unit& u, int wr, int wc, int lane) const {
        const int rr = lane >> 3, c = lane & 7;
        const int col0 = u.pn * BM + wc * 32 + 4 * c; const int rowb = u.pm * BM + wr * 64 + rr;
        u32x2 xr[8][4];
#pragma unroll
        for (int g = 0; g < 8; ++g) { const bf16_t* p_ = xb + (size_t)(rowb + (g >> 2) * HALF + (g & 3) * 16) * ldc + col0;
            xr[g][0] = *(const u32x2*)(p_); xr[g][1] = *(const u32x2*)(p_ + 8 * (size_t)ldc); xr[g][2] = *(const u32x2*)(p_ + HALF); xr[g][3] = *(const u32x2*)(p_ + 8 * (size_t)ldc + HALF); }
        PG8_FENCE();
        lane_exchange(acc, lane);
        PG8_FENCE();
#pragma unroll
        for (int g = 0; g < 8; ++g) { const int ai = g >> 2, m = g & 3; float* q_ = out + (size_t)(rowb + ai * HALF + m * 16) * ldc + col0;
#pragma unroll
            for (int bj = 0; bj < 2; ++bj)
#pragma unroll
                for (int I = 0; I < 2; ++I) { const u32x2 w = xr[g][bj * 2 + I]; f32x4 b;
                    b[0] = __builtin_bit_cast(float, w.x << 16); b[1] = __builtin_bit_cast(float, w.x & 0xffff0000u); b[2] = __builtin_bit_cast(float, w.y << 16); b[3] = __builtin_bit_cast(float, w.y & 0xffff0000u);
                    __builtin_nontemporal_store(b + acc[ai][bj][m][I], (f32x4*)(q_ + (size_t)(8 * I) * ldc + bj * HALF)); } }
    }
};

struct EpiOut6L {
    static constexpr bool PERM = false, AFTER_DRAIN = false; static constexpr int LANE_T = 3; static constexpr bool ZFIRST = ZF_P6;
    const bf16_t* xb; float* out; int ldc;
    __device__ __forceinline__ void run(f32x4 (&acc)[2][2][4][2], const Unit& u, int wr, int wc, int lane) const {
        const int rr = lane >> 3, c = lane & 7;
        const int col0 = u.pn * BM + wc * 32 + 4 * c; const int rowb = u.pm * BM + wr * 64 + rr;
        u32x2 xr[8][4];
#pragma unroll
        for (int g = 0; g < 8; ++g) { const bf16_t* p_ = xb + (size_t)(rowb + (g >> 2) * HALF + (g & 3) * 16) * ldc + col0;
            xr[g][0] = __builtin_nontemporal_load((const u32x2*)(p_)); xr[g][1] = __builtin_nontemporal_load((const u32x2*)(p_ + 8 * (size_t)ldc)); xr[g][2] = __builtin_nontemporal_load((const u32x2*)(p_ + HALF)); xr[g][3] = __builtin_nontemporal_load((const u32x2*)(p_ + 8 * (size_t)ldc + HALF)); }
        PG8_FENCE();
        lane_exchange(acc, lane);
        PG8_FENCE();
#pragma unroll
        for (int g = 0; g < 8; ++g) { const int ai = g >> 2, m = g & 3; float* q_ = out + (size_t)(rowb + ai * HALF + m * 16) * ldc + col0;
#pragma unroll
            for (int bj = 0; bj < 2; ++bj)
#pragma unroll
                for (int I = 0; I < 2; ++I) { const u32x2 w = xr[g][bj * 2 + I]; f32x4 b;
                    b[0] = __builtin_bit_cast(float, w.x << 16); b[1] = __builtin_bit_cast(float, w.x & 0xffff0000u); b[2] = __builtin_bit_cast(float, w.y << 16); b[3] = __builtin_bit_cast(float, w.y & 0xffff0000u);
                    *(f32x4*)(q_ + (size_t)(8 * I) * ldc + bj * HALF) = b + acc[ai][bj][m][I]; } }
    }
};
struct EpiResid6L {
    static constexpr bool PERM = false, AFTER_DRAIN = false; static constexpr int LANE_T = 3; static constexpr bool ZFIRST = ZF_DEFAULT;
    const float* base; bf16_t* xb; float* ssq; int ldc;
    __device__ __forceinline__ void run(f32x4 (&acc)[2][2][4][2], const Unit& u, int wr, int wc, int lane) const {
        const int rr = lane >> 3, c = lane & 7;
        const int col0 = u.pn * BM + wc * 32 + 4 * c; const int rowb = u.pm * BM + wr * 64 + rr;
        f32x4 b0[4], b1[4], b2[4];
#define PG8_R5_LOAD(B, g) do { const float* p_ = base + (size_t)(rowb + ((g) >> 2) * HALF + ((g) & 3) * 16) * ldc + col0; B[0] = __builtin_nontemporal_load((const f32x4*)(p_)); B[1] = __builtin_nontemporal_load((const f32x4*)(p_ + 8 * (size_t)ldc)); B[2] = __builtin_nontemporal_load((const f32x4*)(p_ + HALF)); B[3] = __builtin_nontemporal_load((const f32x4*)(p_ + 8 * (size_t)ldc + HALF)); } while (0)
#define PG8_R5_PROC(B, g) do { const int ai_ = (g) >> 2, m_ = (g) & 3; const int r_ = rowb + ai_ * HALF + m_ * 16; bf16_t* q_ = xb + (size_t)r_ * ldc + col0; \
            _Pragma("unroll") for (int I = 0; I < 2; ++I) { float s_ = 0.f; \
                _Pragma("unroll") for (int bj = 0; bj < 2; ++bj) { const f32x4 o = B[bj * 2 + I] + acc[ai_][bj][m_][I]; \
                    u32x2 w; w.x = cvt_pk_bf16(o[0], o[1]); w.y = cvt_pk_bf16(o[2], o[3]); *(u32x2*)(q_ + (size_t)(8 * I) * ldc + bj * HALF) = w; s_ += (o[0] * o[0] + o[1] * o[1]) + (o[2] * o[2] + o[3] * o[3]); } \
                s_ = oct_sum(s_); if (c == 0) ssq[(size_t)(r_ + 8 * I) * 16 + u.pn * 4 + wc] = s_; } } while (0)
        PG8_R5_LOAD(b0, 0); PG8_R5_LOAD(b1, 1); PG8_FENCE();
        lane_exchange(acc, lane);
        PG8_FENCE(); PG8_R5_LOAD(b2, 2); PG8_FENCE(); PG8_R5_PROC(b0, 0); PG8_FENCE();
        PG8_R5_LOAD(b0, 3); PG8_FENCE(); PG8_R5_PROC(b1, 1); PG8_FENCE();
        PG8_R5_LOAD(b1, 4); PG8_FENCE(); PG8_R5_PROC(b2, 2); PG8_FENCE();
        PG8_R5_LOAD(b2, 5); PG8_FENCE(); PG8_R5_PROC(b0, 3); PG8_FENCE();
        PG8_R5_LOAD(b0, 6); PG8_FENCE(); PG8_R5_PROC(b1, 4); PG8_FENCE();
        PG8_R5_LOAD(b1, 7); PG8_FENCE(); PG8_R5_PROC(b2, 5); PG8_FENCE();
        PG8_R5_PROC(b0, 6); PG8_FENCE(); PG8_R5_PROC(b1, 7);
#undef PG8_R5_LOAD
#undef PG8_R5_PROC
    }
};

struct EpiResid7 {
    static constexpr bool PERM = false, AFTER_DRAIN = false; static constexpr int LANE_T = 3; static constexpr bool ZFIRST = ZF_P4;
    const float* base; bf16_t* xb; float* ssq; int ldc;
    __device__ __forceinline__ void run(f32x4 (&acc)[2][2][4][2], const Unit& u, int wr, int wc, int lane) const {
        const int rr = lane >> 3, c = lane & 7;
        const int col0 = u.pn * BM + wc * 32 + 4 * c; const int rowb = u.pm * BM + wr * 64 + rr;
        f32x4 b0[4], b1[4], b2[4];
        float k0_ = 0.f, k1_ = 0.f;
#define PG8_R5_LOAD(B, g) do { const float* p_ = base + (size_t)(rowb + ((g) >> 2) * HALF + ((g) & 3) * 16) * ldc + col0; B[0] = __builtin_nontemporal_load((const f32x4*)(p_)); B[1] = __builtin_nontemporal_load((const f32x4*)(p_ + 8 * (size_t)ldc)); B[2] = __builtin_nontemporal_load((const f32x4*)(p_ + HALF)); B[3] = __builtin_nontemporal_load((const f32x4*)(p_ + 8 * (size_t)ldc + HALF)); } while (0)
#define PG8_R5_PROC(B, g) do { const int ai_ = (g) >> 2, m_ = (g) & 3; const int r_ = rowb + ai_ * HALF + m_ * 16; bf16_t* q_ = xb + (size_t)r_ * ldc + col0; \
            _Pragma("unroll") for (int I = 0; I < 2; ++I) { float s_ = 0.f; \
                _Pragma("unroll") for (int bj = 0; bj < 2; ++bj) { const f32x4 o = B[bj * 2 + I] + acc[ai_][bj][m_][I]; \
                    u32x2 w; w.x = cvt_pk_bf16(o[0], o[1]); w.y = cvt_pk_bf16(o[2], o[3]); *(u32x2*)(q_ + (size_t)(8 * I) * ldc + bj * HALF) = w; s_ += (o[0] * o[0] + o[1] * o[1]) + (o[2] * o[2] + o[3] * o[3]); } \
                s_ = oct_sum(s_); if ((2 * (g) + I) < 8) { k0_ = (c == ((2 * (g) + I) & 7)) ? s_ : k0_; } else { k1_ = (c == ((2 * (g) + I) & 7)) ? s_ : k1_; } } } while (0)
        PG8_R5_LOAD(b0, 0); PG8_R5_LOAD(b1, 1); PG8_FENCE();
        lane_exchange(acc, lane);
        PG8_FENCE(); PG8_R5_LOAD(b2, 2); PG8_FENCE(); PG8_R5_PROC(b0, 0); PG8_FENCE();
        PG8_R5_LOAD(b0, 3); PG8_FENCE(); PG8_R5_PROC(b1, 1); PG8_FENCE();
        PG8_R5_LOAD(b1, 4); PG8_FENCE(); PG8_R5_PROC(b2, 2); PG8_FENCE();
        PG8_R5_LOAD(b2, 5); PG8_FENCE(); PG8_R5_PROC(b0, 3); PG8_FENCE();
        PG8_R5_LOAD(b0, 6); PG8_FENCE(); PG8_R5_PROC(b1, 4); PG8_FENCE();
        PG8_R5_LOAD(b1, 7); PG8_FENCE(); PG8_R5_PROC(b2, 5); PG8_FENCE();
        PG8_R5_PROC(b0, 6); PG8_FENCE(); PG8_R5_PROC(b1, 7);
        { const int rw_ = rowb + (c >> 1) * 16 + 8 * (c & 1); ssq[(size_t)rw_ * 16 + u.pn * 4 + wc] = k0_; ssq[(size_t)(rw_ + HALF) * 16 + u.pn * 4 + wc] = k1_; }
#undef PG8_R5_LOAD
#undef PG8_R5_PROC
    }
};

struct EpiProj4 {
    static constexpr bool PERM = true, AFTER_DRAIN = false; static constexpr int LANE_T = 0; static constexpr bool ZFIRST = ZF_P1;
    bf16_t* O; int ldc; const int* pos;
    __device__ __forceinline__ void operator()(const f32x4 (&acc)[2][2][4][2], const Unit& u, int wr, int wc, int fr, int fq) const {
        const int row0 = u.pm * BM + wr * 64 + fr;
        if (u.pn < 4) {
            const float ksc = (u.pn >= 2) ? 0.125f : 1.0f; const int col_lo = u.pn * BM + wc * 64 + 8 * fq;
            f32x4 c0_[4], c1_[4], c2_[4];
            float inv[8]; int pp[8];
#pragma unroll
            for (int jj = 0; jj < 8; ++jj) inv[jj] = __builtin_amdgcn_exp2f(-(float)(8 * fq + jj) * (13.287712379549449f / 32.0f));
#pragma unroll
            for (int g = 0; g < 8; ++g) pp[g] = pos[row0 + (g >> 2) * HALF + (g & 3) * 16];
            PG8_FENCE();
#define PG8_P2_LOAD(C, g) do { const float p_ = (float)pp[g]; _Pragma("unroll") for (int jj = 0; jj < 8; ++jj) { const float ang_ = p_ * inv[jj]; const float rev_ = ang_ * 0.15915494f; \
                const float x_ = __builtin_amdgcn_fractf(rev_) + (__builtin_fmaf(ang_, 0.15915494f, -rev_) + ang_ * 6.4206383e-9f);     \
                C[jj >> 1][(jj & 1) * 2] = __builtin_amdgcn_cosf(x_); C[jj >> 1][(jj & 1) * 2 + 1] = __builtin_amdgcn_sinf(x_); } } while (0)
#define PG8_P2_PROC(C, g) do { const int ai_ = (g) >> 2, m_ = (g) & 3; bf16_t* rowp = O + (size_t)(row0 + ai_ * HALF + m_ * 16) * ldc + col_lo; \
                const f32x4 a0 = acc[ai_][0][m_][0], a1 = acc[ai_][0][m_][1], b0 = acc[ai_][1][m_][0], b1 = acc[ai_][1][m_][1]; float lo[8], hi[8]; \
                lo[0] = a0[0] * C[0][0] - b0[0] * C[0][1]; hi[0] = b0[0] * C[0][0] + a0[0] * C[0][1]; lo[1] = a0[1] * C[0][2] - b0[1] * C[0][3]; hi[1] = b0[1] * C[0][2] + a0[1] * C[0][3]; \
                lo[2] = a0[2] * C[1][0] - b0[2] * C[1][1]; hi[2] = b0[2] * C[1][0] + a0[2] * C[1][1]; lo[3] = a0[3] * C[1][2] - b0[3] * C[1][3]; hi[3] = b0[3] * C[1][2] + a0[3] * C[1][3]; \
                lo[4] = a1[0] * C[2][0] - b1[0] * C[2][1]; hi[4] = b1[0] * C[2][0] + a1[0] * C[2][1]; lo[5] = a1[1] * C[2][2] - b1[1] * C[2][3]; hi[5] = b1[1] * C[2][2] + a1[1] * C[2][3]; \
                lo[6] = a1[2] * C[3][0] - b1[2] * C[3][1]; hi[6] = b1[2] * C[3][0] + a1[2] * C[3][1]; lo[7] = a1[3] * C[3][2] - b1[3] * C[3][3]; hi[7] = b1[3] * C[3][2] + a1[3] * C[3][3]; \
                u32x4 w; w.x = cvt_pk_bf16(lo[0] * ksc, lo[1] * ksc); w.y = cvt_pk_bf16(lo[2] * ksc, lo[3] * ksc); w.z = cvt_pk_bf16(lo[4] * ksc, lo[5] * ksc); w.w = cvt_pk_bf16(lo[6] * ksc, lo[7] * ksc); \
                *(u32x4*)rowp = w; \
                w.x = cvt_pk_bf16(hi[0] * ksc, hi[1] * ksc); w.y = cvt_pk_bf16(hi[2] * ksc, hi[3] * ksc); w.z = cvt_pk_bf16(hi[4] * ksc, hi[5] * ksc); w.w = cvt_pk_bf16(hi[6] * ksc, hi[7] * ksc); \
                *(u32x4*)(rowp + 32) = w; } while (0)
            PG8_P2_LOAD(c0_, 0); PG8_P2_LOAD(c1_, 1); PG8_FENCE();
            PG8_P2_LOAD(c2_, 2); PG8_FENCE(); PG8_P2_PROC(c0_, 0); PG8_FENCE();
            PG8_P2_LOAD(c0_, 3); PG8_FENCE(); PG8_P2_PROC(c1_, 1); PG8_FENCE();
            PG8_P2_LOAD(c1_, 4); PG8_FENCE(); PG8_P2_PROC(c2_, 2); PG8_FENCE();
            PG8_P2_LOAD(c2_, 5); PG8_FENCE(); PG8_P2_PROC(c0_, 3); PG8_FENCE();
            PG8_P2_LOAD(c0_, 6); PG8_FENCE(); PG8_P2_PROC(c1_, 4); PG8_FENCE();
            PG8_P2_LOAD(c1_, 7); PG8_FENCE(); PG8_P2_PROC(c2_, 5); PG8_FENCE();
            PG8_P2_PROC(c0_, 6); PG8_FENCE(); PG8_P2_PROC(c1_, 7);
#undef PG8_P2_LOAD
#undef PG8_P2_PROC
        } else {
            const int col0 = u.pn * BM + wc * 32 + 8 * fq;
#pragma unroll
            for (int ai = 0; ai < 2; ++ai)
#pragma unroll
                for (int m = 0; m < 4; ++m) { bf16_t* rowp = O + (size_t)(row0 + ai * HALF + m * 16) * ldc + col0;
#pragma unroll
                    for (int bj = 0; bj < 2; ++bj) { const f32x4 v0 = acc[ai][bj][m][0], v1 = acc[ai][bj][m][1];
                        u32x4 w; w.x = cvt_pk_bf16(v0[0], v0[1]); w.y = cvt_pk_bf16(v0[2], v0[3]); w.z = cvt_pk_bf16(v1[0], v1[1]); w.w = cvt_pk_bf16(v1[2], v1[3]);
                        if (!(u.pn == 9 && bj == 1 && wc > 0)) *(u32x4*)(rowp + bj * HALF) = w; } }
        }
    }
};

struct EpiSwiGLU3 {
    static constexpr bool PERM = true, AFTER_DRAIN = false; static constexpr int LANE_T = 0; static constexpr bool ZFIRST = ZF_P5;
    bf16_t* O; int ldc; const PG8_LAS int* plist; const PG8_LAS float* rtab;
    __device__ __forceinline__ void operator()(const f32x4 (&acc)[2][2][4][2], const Unit& u, int wr, int wc, int fr, int fq) const {
        const int col0 = u.pn * HALF + wc * 32 + 8 * fq; const int rowb = u.pm * BM + wr * 64 + fr;
        int slot = 0; { const int n = plist[0]; for (int k = 1; k < n; ++k) if (plist[1 + k] == u.pm) slot = k; }
        const PG8_LAS float* rp = rtab + slot * 256 + wr * 64 + fr;
        float rs[8];
#pragma unroll
        for (int g = 0; g < 8; ++g) rs[g] = rp[(g >> 2) * HALF + (g & 3) * 16];
#pragma unroll
        for (int g = 0; g < 8; ++g) { const int ai = g >> 2, m = g & 3; const float r_ = rs[g], c1 = -1.4426950408889634f * r_, r2 = r_ * r_; float v[8];
#pragma unroll
            for (int n = 0; n < 2; ++n)
#pragma unroll
                for (int e = 0; e < 4; ++e) { const float gt = acc[ai][0][m][n][e], up = acc[ai][1][m][n][e];
                    v[n * 4 + e] = (gt * up) * (r2 * __builtin_amdgcn_rcpf(1.0f + __builtin_amdgcn_exp2f(gt * c1))); }
            u32x4 w; w.x = cvt_pk_bf16(v[0], v[1]); w.y = cvt_pk_bf16(v[2], v[3]); w.z = cvt_pk_bf16(v[4], v[5]); w.w = cvt_pk_bf16(v[6], v[7]);
            __builtin_nontemporal_store(w, (u32x4*)(O + (size_t)(rowb + ai * HALF + m * 16) * ldc + col0)); }
    }
};

struct EpiProj5 {
    static constexpr bool PERM = true, AFTER_DRAIN = false; static constexpr int LANE_T = 0; static constexpr bool ZFIRST = ZF_P1;
    bf16_t* O; int ldc; const int* pos;
    __device__ __forceinline__ void operator()(const f32x4 (&acc)[2][2][4][2], const Unit& u, int wr, int wc, int fr, int fq) const {
        const int row0 = u.pm * BM + wr * 64 + fr;
        if (u.pn < 4) {
            const float ksc = (u.pn >= 2) ? 0.125f : 1.0f; const int col_lo = u.pn * BM + wc * 64 + 8 * fq;
            f32x4 c0_[4];
            float inv[8]; int pp[8];
            int fql_ = fq; asm volatile("" : "+v"(fql_));
#pragma unroll
            for (int jj = 0; jj < 8; ++jj) inv[jj] = __builtin_amdgcn_exp2f(-(float)(8 * fql_ + jj) * (13.287712379549449f / 32.0f));
#pragma unroll
            for (int g = 0; g < 8; ++g) pp[g] = pos[row0 + (g >> 2) * HALF + (g & 3) * 16];
            PG8_FENCE();
#define PG8_P2_LOAD(C, g) do { const float p_ = (float)pp[g]; _Pragma("unroll") for (int jj = 0; jj < 8; ++jj) { const float ang_ = p_ * inv[jj]; const float rev_ = ang_ * 0.15915494f; \
                const float x_ = __builtin_amdgcn_fractf(rev_) + (__builtin_fmaf(ang_, 0.15915494f, -rev_) + ang_ * 6.4206383e-9f);     \
                C[jj >> 1][(jj & 1) * 2] = __builtin_amdgcn_cosf(x_); C[jj >> 1][(jj & 1) * 2 + 1] = __builtin_amdgcn_sinf(x_); } } while (0)
#define PG8_P2_PROC(C, g) do { const int ai_ = (g) >> 2, m_ = (g) & 3; bf16_t* rowp = O + (size_t)(row0 + ai_ * HALF + m_ * 16) * ldc + col_lo; \
                const f32x4 a0 = acc[ai_][0][m_][0], a1 = acc[ai_][0][m_][1], b0 = acc[ai_][1][m_][0], b1 = acc[ai_][1][m_][1]; float lo[8], hi[8]; \
                lo[0] = a0[0] * C[0][0] - b0[0] * C[0][1]; hi[0] = b0[0] * C[0][0] + a0[0] * C[0][1]; lo[1] = a0[1] * C[0][2] - b0[1] * C[0][3]; hi[1] = b0[1] * C[0][2] + a0[1] * C[0][3]; \
                lo[2] = a0[2] * C[1][0] - b0[2] * C[1][1]; hi[2] = b0[2] * C[1][0] + a0[2] * C[1][1]; lo[3] = a0[3] * C[1][2] - b0[3] * C[1][3]; hi[3] = b0[3] * C[1][2] + a0[3] * C[1][3]; \
                lo[4] = a1[0] * C[2][0] - b1[0] * C[2][1]; hi[4] = b1[0] * C[2][0] + a1[0] * C[2][1]; lo[5] = a1[1] * C[2][2] - b1[1] * C[2][3]; hi[5] = b1[1] * C[2][2] + a1[1] * C[2][3]; \
                lo[6] = a1[2] * C[3][0] - b1[2] * C[3][1]; hi[6] = b1[2] * C[3][0] + a1[2] * C[3][1]; lo[7] = a1[3] * C[3][2] - b1[3] * C[3][3]; hi[7] = b1[3] * C[3][2] + a1[3] * C[3][3]; \
                u32x4 w; w.x = cvt_pk_bf16(lo[0] * ksc, lo[1] * ksc); w.y = cvt_pk_bf16(lo[2] * ksc, lo[3] * ksc); w.z = cvt_pk_bf16(lo[4] * ksc, lo[5] * ksc); w.w = cvt_pk_bf16(lo[6] * ksc, lo[7] * ksc); \
                *(u32x4*)rowp = w; \
                w.x = cvt_pk_bf16(hi[0] * ksc, hi[1] * ksc); w.y = cvt_pk_bf16(hi[2] * ksc, hi[3] * ksc); w.z = cvt_pk_bf16(hi[4] * ksc, hi[5] * ksc); w.w = cvt_pk_bf16(hi[6] * ksc, hi[7] * ksc); \
                *(u32x4*)(rowp + 32) = w; } while (0)
            PG8_P2_LOAD(c0_, 0); PG8_P2_PROC(c0_, 0); PG8_FENCE();
            PG8_P2_LOAD(c0_, 1); PG8_P2_PROC(c0_, 1); PG8_FENCE();
            PG8_P2_LOAD(c0_, 2); PG8_P2_PROC(c0_, 2); PG8_FENCE();
            PG8_P2_LOAD(c0_, 3); PG8_P2_PROC(c0_, 3); PG8_FENCE();
            PG8_P2_LOAD(c0_, 4); PG8_P2_PROC(c0_, 4); PG8_FENCE();
            PG8_P2_LOAD(c0_, 5); PG8_P2_PROC(c0_, 5); PG8_FENCE();
            PG8_P2_LOAD(c0_, 6); PG8_P2_PROC(c0_, 6); PG8_FENCE();
            PG8_P2_LOAD(c0_, 7); PG8_P2_PROC(c0_, 7); PG8_FENCE();
#undef PG8_P2_LOAD
#undef PG8_P2_PROC
        } else {
            const int col0 = u.pn * BM + wc * 32 + 8 * fq;
#pragma unroll
            for (int ai = 0; ai < 2; ++ai)
#pragma unroll
                for (int m = 0; m < 4; ++m) { bf16_t* rowp = O + (size_t)(row0 + ai * HALF + m * 16) * ldc + col0;
#pragma unroll
                    for (int bj = 0; bj < 2; ++bj) { const f32x4 v0 = acc[ai][bj][m][0], v1 = acc[ai][bj][m][1];
                        u32x4 w; w.x = cvt_pk_bf16(v0[0], v0[1]); w.y = cvt_pk_bf16(v0[2], v0[3]); w.z = cvt_pk_bf16(v1[0], v1[1]); w.w = cvt_pk_bf16(v1[2], v1[3]);
                        if (!(u.pn == 9 && bj == 1 && wc > 0)) *(u32x4*)(rowp + bj * HALF) = w; } }
        }
    }
};

struct EpiSwiGLU4 {
    static constexpr bool PERM = true, AFTER_DRAIN = false; static constexpr int LANE_T = 0; static constexpr bool ZFIRST = ZF_P5;
    bf16_t* O; int ldc; const PG8_LAS int* plist; const PG8_LAS float* rtab;
    __device__ __forceinline__ void operator()(const f32x4 (&acc)[2][2][4][2], const Unit& u, int wr, int wc, int fr, int fq) const {
        const int col0 = u.pn * HALF + wc * 32 + 8 * fq; const int rowb = u.pm * BM + wr * 64 + fr;
        int slot = 0; { const int n = plist[0]; for (int k = 1; k < n; ++k) if (plist[1 + k] == u.pm) slot = k; }
        const PG8_LAS float* rp = rtab + slot * 256 + wr * 64 + fr;
        float rs[8];
#pragma unroll
        for (int g = 0; g < 8; ++g) rs[g] = rp[(g >> 2) * HALF + (g & 3) * 16];
#pragma unroll
        for (int g = 0; g < 8; ++g) { const int ai = g >> 2, m = g & 3; const float r_ = rs[g], c1 = -1.4426950408889634f * r_, ir2 = __builtin_amdgcn_rcpf(r_ * r_); float v[8];
#pragma unroll
            for (int n = 0; n < 2; ++n)
#pragma unroll
                for (int e = 0; e < 4; ++e) { const float gt = acc[ai][0][m][n][e], up = acc[ai][1][m][n][e];
                    v[n * 4 + e] = (gt * up) * __builtin_amdgcn_rcpf(__builtin_fmaf(__builtin_amdgcn_exp2f(gt * c1), ir2, ir2)); }
            u32x4 w; w.x = cvt_pk_bf16(v[0], v[1]); w.y = cvt_pk_bf16(v[2], v[3]); w.z = cvt_pk_bf16(v[4], v[5]); w.w = cvt_pk_bf16(v[6], v[7]);
            __builtin_nontemporal_store(w, (u32x4*)(O + (size_t)(rowb + ai * HALF + m * 16) * ldc + col0)); }
    }
};
template <class Epi, class Sched, bool ALIGN_EPI = false, bool SP2 = false>
__device__ __forceinline__ void gemm_phase(PG8_LAS unsigned char* lds, const Gemm g, const Sched& S, const Epi& E) {
    int tid_ = threadIdx.x; asm volatile("" : "+v"(tid_));
    const int tid = tid_, wid = __builtin_amdgcn_readfirstlane(tid >> 6), lane = tid & 63, wr = wid >> 2, wc = wid & 3, fr = lane & 15, fq = lane >> 4;
    const int K = g.K, nt = K / BK;
    unsigned voffA, voffB;
    { int R, C; stage_rc(tid * 16, R, C); const int Rb = Epi::PERM ? ((R & ~31) + perm32(R & 31)) : R;
      voffA = (unsigned)(R * K + C) * 2u; voffB = (unsigned)(Rb * K + C) * 2u; }
    const size_t q64 = (size_t)64 * K * 2;
    const size_t kstep = (size_t)(BK * 2);
    const size_t hstep = (size_t)HALF * K * 2;
    const size_t tstep = 2 * hstep;
    const unsigned ldsw = (unsigned)wid * 1024u;
    const int aoff = lds_byte(wr * 64 + fr, fq * 8), boff = lds_byte(wc * 32 + fr, fq * 8);
#define PG8_SA(b, h) (((b) * 2 + (h)) * HTB)
#define PG8_SB(b, h) ((4 + (b) * 2 + (h)) * HTB)
#define PG8_STAGE(bufoff, gbase, voff) do { _Pragma("unroll") for (int _i = 0; _i < 2; ++_i) \
        __builtin_amdgcn_global_load_lds((const unsigned*)((const char*)(gbase) + (size_t)_i * q64 + (voff)), (PG8_LAS unsigned*)(lds + (bufoff) + ldsw + _i * 8192), 16, 0, 0); } while (0)
#define PG8_LDA(dst, b, h) do { _Pragma("unroll") for (int m = 0; m < 4; ++m) _Pragma("unroll") for (int k = 0; k < 2; ++k) dst[m][k] = *(const PG8_LAS bf16x8*)(lds + PG8_SA(b, h) + aoff + m * 2048 + k * 1024); } while (0)
#define PG8_LDB(dst, b, h) do { _Pragma("unroll") for (int n = 0; n < 2; ++n) _Pragma("unroll") for (int k = 0; k < 2; ++k) dst[n][k] = *(const PG8_LAS bf16x8*)(lds + PG8_SB(b, h) + boff + n * 2048 + k * 1024); } while (0)
#define PG8_MMA(ai, bj, At, Bt) do { __builtin_amdgcn_s_setprio(1); _Pragma("unroll") for (int m = 0; m < 4; ++m) _Pragma("unroll") for (int n = 0; n < 2; ++n) _Pragma("unroll") for (int k = 0; k < 2; ++k) \
        acc[ai][bj][m][n] = __builtin_amdgcn_mfma_f32_16x16x32_bf16(Bt[n][k], At[m][k], acc[ai][bj][m][n], 0, 0, 0); __builtin_amdgcn_s_setprio(0); } while (0)
#define PG8_MMA_Z(ai, bj, At, Bt) do { __builtin_amdgcn_s_setprio(1); _Pragma("unroll") for (int m = 0; m < 4; ++m) _Pragma("unroll") for (int n = 0; n < 2; ++n) { \
        acc[ai][bj][m][n] = __builtin_amdgcn_mfma_f32_16x16x32_bf16(Bt[n][0], At[m][0], (f32x4){0.f, 0.f, 0.f, 0.f}, 0, 0, 0); \
        acc[ai][bj][m][n] = __builtin_amdgcn_mfma_f32_16x16x32_bf16(Bt[n][1], At[m][1], acc[ai][bj][m][n], 0, 0, 0); } __builtin_amdgcn_s_setprio(0); } while (0)
#define PG8_WAIT_V(n) asm volatile("s_waitcnt vmcnt(" #n ")" ::: "memory")
#define PG8_WAIT_L(n) asm volatile("s_waitcnt lgkmcnt(" #n ")" ::: "memory")
#define PG8_BAR __builtin_amdgcn_s_barrier()
#define PG8_SCHED __builtin_amdgcn_sched_barrier(0)
    Unit cur, nxt; int ui = 0;
    if (!S.next(0, cur)) return;
    f32x4 acc[2][2][4][2];
    if constexpr (!Epi::ZFIRST) {
#pragma unroll
    for (int a = 0; a < 2; ++a)
#pragma unroll
        for (int b = 0; b < 2; ++b)
#pragma unroll
            for (int m = 0; m < 4; ++m)
#pragma unroll
                for (int n = 0; n < 2; ++n) acc[a][b][m][n] = (f32x4){0.f, 0.f, 0.f, 0.f};
    }
    bf16x8 At[4][2], B0[2][2], B1[2][2];
    const char* cA = (const char*)g.A + (size_t)cur.pm * tstep; const char* cB = (const char*)g.Bt + (size_t)cur.pn * tstep;
    S.a_ready(cur);
    if constexpr (SP2) {
        PG8_STAGE(PG8_SB(0, 0), cB, voffB); PG8_STAGE(PG8_SB(0, 1), cB + hstep, voffB); PG8_STAGE(PG8_SA(0, 0), cA, voffA); PG8_STAGE(PG8_SA(0, 1), cA + hstep, voffA);
        if (wr == 1) PG8_BAR;
        PG8_WAIT_V(2); PG8_BAR;
        PG8_STAGE(PG8_SB(1, 0), cB + kstep, voffB); PG8_STAGE(PG8_SA(1, 0), cA + kstep, voffA); PG8_STAGE(PG8_SB(1, 1), cB + hstep + kstep, voffB);
        PG8_WAIT_V(6); PG8_BAR;
    } else {
        PG8_STAGE(PG8_SB(0, 0), cB, voffB); PG8_STAGE(PG8_SA(0, 0), cA, voffA); PG8_STAGE(PG8_SB(0, 1), cB + hstep, voffB); PG8_STAGE(PG8_SA(0, 1), cA + hstep, voffA);
        if (wr == 1) PG8_BAR;
        PG8_WAIT_V(4); PG8_BAR;
        PG8_STAGE(PG8_SB(1, 0), cB + kstep, voffB); PG8_STAGE(PG8_SA(1, 0), cA + kstep, voffA); PG8_STAGE(PG8_SB(1, 1), cB + hstep + kstep, voffB);
        PG8_WAIT_V(6); PG8_BAR;
    }
    for (;;) {
        const bool has_next = S.next(ui + 1, nxt);
        const char* nA = has_next ? (const char*)g.A + (size_t)nxt.pm * tstep : cA; const char* nB = has_next ? (const char*)g.Bt + (size_t)nxt.pn * tstep : cB;
        if constexpr (Epi::ZFIRST) { static_assert(SP2, "ZFIRST is written for the SP2 loop"); const int t = 0;
            const bool last = (t == nt - 2);
            const char* a1 = cA + (size_t)(t + 1) * kstep;
            const char* a2 = last ? nA : cA + (size_t)(t + 2) * kstep; const char* b2 = last ? nB : cB + (size_t)(t + 2) * kstep;
            const char* a3 = a2 + kstep; const char* b3 = b2 + kstep;
            if (last && has_next) S.a_ready(nxt);
            if constexpr (SP2) {
            PG8_LDB(B0, 0, 0); PG8_LDB(B1, 0, 1); PG8_SCHED; PG8_LDA(At, 0, 0); PG8_STAGE(PG8_SA(1, 1), a1 + hstep, voffA);
            PG8_WAIT_V(8); PG8_WAIT_L(0); PG8_BAR; PG8_MMA_Z(0, 0, At, B0); PG8_MMA_Z(0, 1, At, B1); PG8_BAR; PG8_SCHED;
            PG8_LDA(At, 0, 1); PG8_STAGE(PG8_SB(0, 0), b2, voffB); PG8_STAGE(PG8_SB(0, 1), b2 + hstep, voffB); PG8_STAGE(PG8_SA(0, 0), a2, voffA);
            PG8_WAIT_V(8); PG8_WAIT_L(0); PG8_BAR; PG8_MMA_Z(1, 0, At, B0); PG8_MMA_Z(1, 1, At, B1); PG8_BAR; PG8_SCHED;
            PG8_LDB(B0, 1, 0); PG8_LDB(B1, 1, 1); PG8_SCHED; PG8_LDA(At, 1, 0); PG8_STAGE(PG8_SA(0, 1), a2 + hstep, voffA);
            PG8_WAIT_V(8); PG8_WAIT_L(0); PG8_BAR; PG8_MMA(0, 0, At, B0); PG8_MMA(0, 1, At, B1); PG8_BAR; PG8_SCHED;
            PG8_LDA(At, 1, 1); PG8_STAGE(PG8_SB(1, 0), b3, voffB); PG8_STAGE(PG8_SB(1, 1), b3 + hstep, voffB); PG8_STAGE(PG8_SA(1, 0), a3, voffA);
            PG8_WAIT_V(8); PG8_WAIT_L(0); PG8_BAR; PG8_MMA(1, 0, At, B0); PG8_MMA(1, 1, At, B1); PG8_BAR; PG8_SCHED;
            } else {
            PG8_LDB(B0, 0, 0); PG8_SCHED; PG8_LDA(At, 0, 0); PG8_STAGE(PG8_SA(1, 1), a1 + hstep, voffA);
            PG8_WAIT_L(8); PG8_BAR; PG8_WAIT_L(0); PG8_MMA(0, 0, At, B0); PG8_BAR; PG8_SCHED;
            PG8_LDB(B1, 0, 1); PG8_STAGE(PG8_SB(0, 0), b2, voffB);
            PG8_BAR; PG8_WAIT_L(0); PG8_MMA(0, 1, At, B1); PG8_BAR;
            PG8_LDA(At, 0, 1); PG8_STAGE(PG8_SA(0, 0), a2, voffA);
            PG8_BAR; PG8_WAIT_L(0); PG8_MMA(1, 0, At, B0); PG8_BAR; PG8_SCHED;
            PG8_STAGE(PG8_SB(0, 1), b2 + hstep, voffB);
            PG8_WAIT_V(6); PG8_BAR; PG8_MMA(1, 1, At, B1); PG8_BAR;
            PG8_LDB(B0, 1, 0); PG8_SCHED; PG8_LDA(At, 1, 0); PG8_STAGE(PG8_SA(0, 1), a2 + hstep, voffA);
            PG8_WAIT_L(8); PG8_BAR; PG8_WAIT_L(0); PG8_MMA(0, 0, At, B0); PG8_BAR; PG8_SCHED;
            PG8_LDB(B1, 1, 1); PG8_STAGE(PG8_SB(1, 0), b3, voffB);
            PG8_BAR; PG8_WAIT_L(0); PG8_MMA(0, 1, At, B1); PG8_BAR;
            PG8_LDA(At, 1, 1); PG8_STAGE(PG8_SA(1, 0), a3, voffA);
            PG8_BAR; PG8_WAIT_L(0); PG8_MMA(1, 0, At, B0); PG8_BAR; PG8_SCHED;
            PG8_STAGE(PG8_SB(1, 1), b3 + hstep, voffB);
            PG8_WAIT_V(6); PG8_BAR; PG8_MMA(1, 1, At, B1); PG8_BAR;
            }
                }
        for (int t = Epi::ZFIRST ? 2 : 0; t < nt; t += 2) {
            const bool last = (t == nt - 2);
            const char* a1 = cA + (size_t)(t + 1) * kstep;
            const char* a2 = last ? nA : cA + (size_t)(t + 2) * kstep; const char* b2 = last ? nB : cB + (size_t)(t + 2) * kstep;
            const char* a3 = a2 + kstep; const char* b3 = b2 + kstep;
            if (last && has_next) S.a_ready(nxt);
            if constexpr (SP2) {
            PG8_LDB(B0, 0, 0); PG8_LDB(B1, 0, 1); PG8_SCHED; PG8_LDA(At, 0, 0); PG8_STAGE(PG8_SA(1, 1), a1 + hstep, voffA);
            PG8_WAIT_V(8); PG8_WAIT_L(0); PG8_BAR; PG8_MMA(0, 0, At, B0); PG8_MMA(0, 1, At, B1); PG8_BAR; PG8_SCHED;
            PG8_LDA(At, 0, 1); PG8_STAGE(PG8_SB(0, 0), b2, voffB); PG8_STAGE(PG8_SB(0, 1), b2 + hstep, voffB); PG8_STAGE(PG8_SA(0, 0), a2, voffA);
            PG8_WAIT_V(8); PG8_WAIT_L(0); PG8_BAR; PG8_MMA(1, 0, At, B0); PG8_MMA(1, 1, At, B1); PG8_BAR; PG8_SCHED;
            PG8_LDB(B0, 1, 0); PG8_LDB(B1, 1, 1); PG8_SCHED; PG8_LDA(At, 1, 0); PG8_STAGE(PG8_SA(0, 1), a2 + hstep, voffA);
            PG8_WAIT_V(8); PG8_WAIT_L(0); PG8_BAR; PG8_MMA(0, 0, At, B0); PG8_MMA(0, 1, At, B1); PG8_BAR; PG8_SCHED;
            PG8_LDA(At, 1, 1); PG8_STAGE(PG8_SB(1, 0), b3, voffB); PG8_STAGE(PG8_SB(1, 1), b3 + hstep, voffB); PG8_STAGE(PG8_SA(1, 0), a3, voffA);
            PG8_WAIT_V(8); PG8_WAIT_L(0); PG8_BAR; PG8_MMA(1, 0, At, B0); PG8_MMA(1, 1, At, B1); PG8_BAR; PG8_SCHED;
            } else {
            PG8_LDB(B0, 0, 0); PG8_SCHED; PG8_LDA(At, 0, 0); PG8_STAGE(PG8_SA(1, 1), a1 + hstep, voffA);
            PG8_WAIT_L(8); PG8_BAR; PG8_WAIT_L(0); PG8_MMA(0, 0, At, B0); PG8_BAR; PG8_SCHED;
            PG8_LDB(B1, 0, 1); PG8_STAGE(PG8_SB(0, 0), b2, voffB);
            PG8_BAR; PG8_WAIT_L(0); PG8_MMA(0, 1, At, B1); PG8_BAR;
            PG8_LDA(At, 0, 1); PG8_STAGE(PG8_SA(0, 0), a2, voffA);
            PG8_BAR; PG8_WAIT_L(0); PG8_MMA(1, 0, At, B0); PG8_BAR; PG8_SCHED;
            PG8_STAGE(PG8_SB(0, 1), b2 + hstep, voffB);
            PG8_WAIT_V(6); PG8_BAR; PG8_MMA(1, 1, At, B1); PG8_BAR;
            PG8_LDB(B0, 1, 0); PG8_SCHED; PG8_LDA(At, 1, 0); PG8_STAGE(PG8_SA(0, 1), a2 + hstep, voffA);
            PG8_WAIT_L(8); PG8_BAR; PG8_WAIT_L(0); PG8_MMA(0, 0, At, B0); PG8_BAR; PG8_SCHED;
            PG8_LDB(B1, 1, 1); PG8_STAGE(PG8_SB(1, 0), b3, voffB);
            PG8_BAR; PG8_WAIT_L(0); PG8_MMA(0, 1, At, B1); PG8_BAR;
            PG8_LDA(At, 1, 1); PG8_STAGE(PG8_SA(1, 0), a3, voffA);
            PG8_BAR; PG8_WAIT_L(0); PG8_MMA(1, 0, At, B0); PG8_BAR; PG8_SCHED;
            PG8_STAGE(PG8_SB(1, 1), b3 + hstep, voffB);
            PG8_WAIT_V(6); PG8_BAR; PG8_MMA(1, 1, At, B1); PG8_BAR;
            }
                }
        if constexpr (ALIGN_EPI) { if (wr == 0) PG8_BAR; }
        if constexpr (Epi::LANE_T == 3) { E.run(acc, cur, wr, wc, lane); S.done(cur); }
        else if constexpr (Epi::LANE_T == 2) {
            const bool hi_ = (lane & 8) != 0; const int rr_ = lane >> 3, c_ = lane & 7; const int pa = (rr_ + 8 * (c_ >> 2) + 16 * (c_ & 3)) << 2;
#pragma unroll
            for (int a = 0; a < 2; ++a)
#pragma unroll
                for (int b = 0; b < 2; ++b)
#pragma unroll
                    for (int m = 0; m < 4; ++m)
#pragma unroll
                        for (int e = 0; e < 4; ++e) { const float a0 = acc[a][b][m][0][e], a1 = acc[a][b][m][1][e]; const float snd = hi_ ? a0 : a1;
                            const float rcv = __int_as_float(__builtin_amdgcn_update_dpp(0, __float_as_int(snd), 0x128, 0xf, 0xf, false));
                            const float d0 = hi_ ? rcv : a0, d1 = hi_ ? a1 : rcv;
                            acc[a][b][m][0][e] = __int_as_float(__builtin_amdgcn_ds_bpermute(pa, __float_as_int(d0))); acc[a][b][m][1][e] = __int_as_float(__builtin_amdgcn_ds_bpermute(pa, __float_as_int(d1))); }
            E(acc, cur, wr, wc, rr_, c_); S.done(cur);
        } else if constexpr (Epi::LANE_T == 1) {
            const int pa = ((lane >> 2) + 16 * (lane & 3)) << 2;
#pragma unroll
            for (int a = 0; a < 2; ++a)
#pragma unroll
                for (int b = 0; b < 2; ++b)
#pragma unroll
                    for (int m = 0; m < 4; ++m)
#pragma unroll
                        for (int n = 0; n < 2; ++n)
#pragma unroll
                            for (int e = 0; e < 4; ++e) { const float t_ = acc[a][b][m][n][e]; acc[a][b][m][n][e] = __int_as_float(__builtin_amdgcn_ds_bpermute(pa, __float_as_int(t_))); }
            E(acc, cur, wr, wc, lane >> 2, lane & 3); S.done(cur);
        } else if constexpr (!Epi::AFTER_DRAIN) { E(acc, cur, wr, wc, fr, fq); S.done(cur); }
        if (!has_next) break;
        if constexpr (!Epi::ZFIRST) {
#pragma unroll
        for (int a = 0; a < 2; ++a)
#pragma unroll
            for (int b = 0; b < 2; ++b)
#pragma unroll
                for (int m = 0; m < 4; ++m)
#pragma unroll
                    for (int n = 0; n < 2; ++n) acc[a][b][m][n] = (f32x4){0.f, 0.f, 0.f, 0.f};
        }
        cur = nxt; cA = nA; cB = nB; ++ui;
        if constexpr (ALIGN_EPI) { if (wr == 1) PG8_BAR; }
    }
    PG8_WAIT_V(0);
    if constexpr (!ALIGN_EPI) { if (wr == 0) PG8_BAR; }
    PG8_BAR;
    if constexpr (Epi::AFTER_DRAIN) { E.fused(acc, cur, wr, wc, fr, fq, lds, wid, lane); S.done(cur); }
#undef PG8_SA
#undef PG8_SB
#undef PG8_STAGE
#undef PG8_LDA
#undef PG8_LDB
#undef PG8_MMA
#undef PG8_MMA_Z
#undef PG8_WAIT_V
#undef PG8_WAIT_L
#undef PG8_BAR
#undef PG8_SCHED
}
}
#define EPI4 EpiResid7
#define EPI6 EpiOut6L
#define EPI1 EpiProj5
#define EPI1_ARG a.pos

constexpr int NWAVES = 8, NTHR = NWAVES * 64;
constexpr int BATCH = 16, SEQ = 4096, DM = 1024, M = BATCH * SEQ;
constexpr int RH = 8, RD = 64, RW = 512, RCH = 128;
constexpr int MH = 8, QRANK = 256, KVRANK = 128, NOPE = 64, ROPE = 32, QKD = 96, VD = 64, MW = 512;
constexpr int NIN = 2464, NINP = 2560, DFF = 2816, NGU = 2 * DFF;
constexpr int C_Q = 0, C_K = 512, C_V = 1024, C_G = 1536, C_CQ = 2048, C_CKV = 2304, C_KR = 2432;
constexpr float EPS = 1e-6f, GN_EPS = 1e-5f;
constexpr int BH = BATCH * MH;
constexpr float ATT_C2 = 0.10206207261596577f * 1.4426950408889634f;

constexpr size_t MiB = 1u << 20;
constexpr size_t WS_LG = 131072;
constexpr size_t WS_ROT = 1 * MiB;
constexpr size_t WS_SSQ = 17 * MiB;
constexpr size_t WS_RSTD = 21 * MiB;
constexpr size_t WS_WIN = 22 * MiB;
constexpr size_t WS_WUQ = 27 * MiB;
constexpr size_t WS_WUKV = 28 * MiB;
constexpr size_t WS_WO = 29 * MiB;
constexpr size_t WS_WGU = 31 * MiB;
constexpr size_t WS_WDN = 42 * MiB;
constexpr size_t WS_XN = 48 * MiB;
constexpr size_t WS_MIX = 176 * MiB;
constexpr size_t WS_PROJ = 304 * MiB;
constexpr size_t WS_QM = 624 * MiB;
constexpr size_t WS_KM = 720 * MiB;
constexpr size_t WS_VM = 816 * MiB;
constexpr size_t WS_ACT = 304 * MiB;
constexpr size_t WS_RB = 880 * MiB;
constexpr size_t WS_END = 912 * MiB;
static_assert(WS_ACT + (size_t)M * DFF * 2 <= WS_KM, "act overlay");

constexpr int LDS_BYTES = 163840;

#define LAS __attribute__((address_space(3)))
typedef unsigned short bf16;
typedef unsigned v4u __attribute__((ext_vector_type(4)));
typedef unsigned v2u __attribute__((ext_vector_type(2)));
typedef float f32x4 __attribute__((ext_vector_type(4)));
#define LDS_WAIT() asm volatile("s_waitcnt lgkmcnt(0)" ::: "memory")
__device__ __forceinline__ unsigned f2bf(float f) { unsigned u = __builtin_bit_cast(unsigned, f); return (u + 0x7fffu + ((u >> 16) & 1u)) >> 16; }
__device__ __forceinline__ unsigned pk2(float lo, float hi) { return f2bf(lo) | (f2bf(hi) << 16); }
__device__ __forceinline__ float bf2f(unsigned short b) { return __builtin_bit_cast(float, (unsigned)b << 16); }
__device__ __forceinline__ float bflo(unsigned w) { return __builtin_bit_cast(float, w << 16); }
__device__ __forceinline__ float bfhi(unsigned w) { return __builtin_bit_cast(float, w & 0xffff0000u); }
__device__ __forceinline__ float wave_sum(float v) {
#pragma unroll
    for (int o = 1; o < 64; o <<= 1) v += __shfl_xor(v, o);
    return v;
}

struct Args { const float* x; const int* pos; const float* g1; const float* w_in; const float* lf; const float* lb; const float* qag; const float* w_uq; const float* kvag; const float* w_ukv;
              const float* qng; const float* kng; const float* w_o; const float* g2; const float* w_gate; const float* w_up; const float* w_down; float* out; unsigned char* ws; };

__device__ __forceinline__ void tr_item(const float* W, int N, const float* ks, bf16* WT, int ldt, int k0, int n0, int orow0, LAS float* scr, int lane) {
    { f32x4 v[8];
#pragma unroll
      for (int i = 0; i < 8; ++i) v[i] = *(const f32x4*)(W + (size_t)(k0 + 8 * i + (lane >> 3)) * N + n0 + 4 * (lane & 7));
#pragma unroll
      for (int i = 0; i < 8; ++i) { const int kk = 8 * i + (lane >> 3); const float s_ = ks ? ks[k0 + kk] : 1.0f;
#pragma unroll
          for (int e = 0; e < 4; ++e) scr[kk * 33 + 4 * (lane & 7) + e] = v[i][e] * s_; } }
    LDS_WAIT(); asm volatile("" ::: "memory");
    const int c = lane & 7;
#pragma unroll
    for (int j = 0; j < 4; ++j) { const int n = (lane >> 3) + 8 * j; const LAS float* s = scr + (8 * c) * 33 + n;
        v4u o; o.x = pk2(s[0 * 33], s[1 * 33]); o.y = pk2(s[2 * 33], s[3 * 33]); o.z = pk2(s[4 * 33], s[5 * 33]); o.w = pk2(s[6 * 33], s[7 * 33]);
        *(v4u*)(WT + (size_t)(orow0 + n) * ldt + k0 + 8 * c) = o; }
    LDS_WAIT(); asm volatile("" ::: "memory");
}
__device__ __forceinline__ void p0_prologue(const Args& a, LAS unsigned char* lds, int gw, int NGW, int wave, int lane) {
    unsigned char* ws = a.ws;
    LAS float* scr = (LAS float*)(lds + wave * 16384);
    bf16* Wt_in = (bf16*)(ws + WS_WIN); bf16* Wt_uq = (bf16*)(ws + WS_WUQ); bf16* Wt_ukv = (bf16*)(ws + WS_WUKV); bf16* Wt_o = (bf16*)(ws + WS_WO); bf16* Wt_gu = (bf16*)(ws + WS_WGU); bf16* Wt_dn = (bf16*)(ws + WS_WDN);
    constexpr int I_IN = (DM / 64) * (NIN / 32), I_UQ = (QRANK / 64) * (MH * QKD / 32), I_UKV = (KVRANK / 64) * (MH * 128 / 32), I_O = (DM / 64) * (DM / 32), I_G = (DM / 64) * (DFF / 32), I_D = (DFF / 64) * (DM / 32);
    constexpr int NITEMS = I_IN + I_UQ + I_UKV + I_O + 2 * I_G + I_D;
    for (int it = gw; it < NITEMS; it += NGW) {
        int r = it;
        if (r < I_IN) { const int nb = NIN / 32, kb = r / nb, n0 = 32 * (r % nb); tr_item(a.w_in, NIN, nullptr, Wt_in, DM, 64 * kb, n0, n0 < 1024 ? (n0 & ~255) + ((n0 >> 5) & 1) * 128 + ((n0 >> 6) & 3) * 32 : n0, scr, lane); continue; } r -= I_IN;
        if (r < I_UQ) { const int nb = MH * QKD / 32, kb = r / nb, n0 = 32 * (r % nb); tr_item(a.w_uq, MH * QKD, a.qag, Wt_uq, QRANK, 64 * kb, n0, n0, scr, lane); continue; } r -= I_UQ;
        if (r < I_UKV) { const int nb = MH * 128 / 32, kb = r / nb, n0 = 32 * (r % nb); tr_item(a.w_ukv, MH * 128, a.kvag, Wt_ukv, KVRANK, 64 * kb, n0, n0, scr, lane); continue; } r -= I_UKV;
        if (r < I_O) { const int nb = DM / 32, kb = r / nb, n0 = 32 * (r % nb); tr_item(a.w_o, DM, nullptr, Wt_o, DM, 64 * kb, n0, n0, scr, lane); continue; } r -= I_O;
        if (r < I_G) { const int nb = DFF / 32, kb = r / nb, n0 = 32 * (r % nb); tr_item(a.w_gate, DFF, a.g2, Wt_gu, DM, 64 * kb, n0, (n0 / 128) * 256 + (n0 % 128), scr, lane); continue; } r -= I_G;
        if (r < I_G) { const int nb = DFF / 32, kb = r / nb, n0 = 32 * (r % nb); tr_item(a.w_up, DFF, a.g2, Wt_gu, DM, 64 * kb, n0, (n0 / 128) * 256 + 128 + (n0 % 128), scr, lane); continue; } r -= I_G;
        { const int nb = DM / 32, kb = r / nb, n0 = 32 * (r % nb); tr_item(a.w_down, DM, nullptr, Wt_dn, DFF, 64 * kb, n0, n0, scr, lane); }
    }
    if (gw == 0 && lane < 2 * RH) ((float*)(ws + WS_LG))[lane] = (float)(-log1p(exp(-(double)(lane < RH ? a.lf[lane] : a.lb[lane - RH]))) * 1.4426950408889634);
    { const int gt = gw * 64 + lane, NGT = NGW * 64; v4u z = {0u, 0u, 0u, 0u}; v4u* p = (v4u*)(Wt_in + (size_t)NIN * DM);
      for (int i = gt; i < (NINP - NIN) * DM / 8; i += NGT) p[i] = z; }
    { bf16* XN = (bf16*)(ws + WS_XN); f32x4 gv[4];
#pragma unroll
      for (int j = 0; j < 4; ++j) gv[j] = ((const f32x4*)a.g1)[lane + 64 * j];
      for (int m = gw; m < M; m += NGW) { const f32x4* xr = (const f32x4*)(a.x + (size_t)m * DM) + lane; f32x4 v[4]; float s = 0.f;
#pragma unroll
          for (int j = 0; j < 4; ++j) { v[j] = xr[64 * j]; s += (v[j].x * v[j].x + v[j].y * v[j].y) + (v[j].z * v[j].z + v[j].w * v[j].w); }
          const float rstd = 1.0f / sqrtf(wave_sum(s) * (1.f / DM) + EPS);
          unsigned long long* o8 = (unsigned long long*)(XN + (size_t)m * DM) + lane;
#pragma unroll
          for (int j = 0; j < 4; ++j) { const f32x4 y = v[j] * rstd * gv[j]; o8[64 * j] = (unsigned long long)pk2(y.x, y.y) | ((unsigned long long)pk2(y.z, y.w) << 32); } } }
}

namespace p2f {
using bf16x8 = __attribute__((ext_vector_type(8))) short;
using f32x16 = __attribute__((ext_vector_type(16))) float;
constexpr int WQ_BYTES = QKD * QRANK * 2, WKV_BYTES = 128 * KVRANK * 2;
constexpr int QST = 208, VST = 144;
constexpr int A_STAGE = 2 * WQ_BYTES, A_STAGE_W = 32 * QST;
constexpr int B_STAGE = 2 * WKV_BYTES, B_STAGE_W = 32 * QST + 32 * VST;
constexpr int L_G = 156672;
static_assert(A_STAGE + 8 * A_STAGE_W <= L_G && B_STAGE + 8 * B_STAGE_W <= L_G && L_G + 768 <= LDS_BYTES - 64, "P2 LDS map");
__device__ __forceinline__ int crow(int r, int hi) { return (r & 3) + 8 * (r >> 2) + 4 * hi; }
__device__ __forceinline__ float swap_add(float v) { auto rr = __builtin_amdgcn_permlane32_swap(__float_as_uint(v), __float_as_uint(v), false, false); return __uint_as_float(rr[0]) + __uint_as_float(rr[1]); }
__device__ __forceinline__ float sumsq8(bf16x8 v) { float s = 0.f;
#pragma unroll
  for (int j = 0; j < 8; ++j) { const float f = bf2f((unsigned short)v[j]); s += f * f; } return s; }
typedef float f32x2_t __attribute__((ext_vector_type(2))); typedef __bf16 bf16x2_t __attribute__((ext_vector_type(2)));
__device__ __forceinline__ unsigned cvt2(float lo, float hi) { f32x2_t v = {lo, hi}; bf16x2_t b = __builtin_convertvector(v, bf16x2_t); return __builtin_bit_cast(unsigned, b); }
__device__ __forceinline__ v2u pk4(float a, float b, float c, float d) { v2u w; w.x = cvt2(a, b); w.y = cvt2(c, d); return w; }
__device__ __forceinline__ void glds16(const void* gsrc, unsigned lds_dst) { unsigned keep;
  asm volatile("s_mov_b32 %0, m0\n\ts_mov_b32 m0, %2\n\ts_nop 0\n\tglobal_load_lds_dwordx4 %1, off\n\ts_mov_b32 m0, %0" : "=&s"(keep) : "v"(gsrc), "s"(lds_dst) : "memory"); }
#define P2_WAIT_BAR() asm volatile("s_waitcnt vmcnt(0) lgkmcnt(0)\n\ts_barrier" ::: "memory")
#define P2_WAIT_BAR_N(N) asm volatile("s_waitcnt vmcnt(" #N ") lgkmcnt(0)\n\ts_barrier" ::: "memory")
__device__ __forceinline__ void run(const Args& a, unsigned char* lds, int bid, int G) {
  unsigned char* ws = a.ws;
  const bf16* PROJ = (const bf16*)(ws + WS_PROJ); const bf16* Wt_uq = (const bf16*)(ws + WS_WUQ); const bf16* Wt_ukv = (const bf16*)(ws + WS_WUKV);
  bf16* QM = (bf16*)(ws + WS_QM); bf16* KM = (bf16*)(ws + WS_KM); bf16* VM = (bf16*)(ws + WS_VM);
  int tid_ = threadIdx.x; asm volatile("" : "+v"(tid_));
  const int tid = tid_, lane = tid & 63, r32 = lane & 31, hi = lane >> 5; const int wid = __builtin_amdgcn_readfirstlane(tid >> 6);
  const unsigned lds0 = (unsigned)(uintptr_t)lds;
  float* gl = (float*)(lds + L_G);
  __syncthreads();
  if (tid < 96) gl[tid] = a.qng[tid]; else if (tid < 192) gl[tid] = a.kng[tid - 96];
  for (int tb = bid; tb < M / 256; tb += G) {
    const int m0 = tb * 256 + wid * 32, m = m0 + r32, b = m / SEQ, s = m % SEQ, s0 = m0 % SEQ;
    const bf16* prow = PROJ + (size_t)m * NINP;
    const float posf = (float)a.pos[m];
    float rotx[8];
#pragma unroll
    for (int r = 0; r < 8; ++r) { const float ang_ = posf * __builtin_amdgcn_exp2f(-(float)crow(r, hi) * (13.287712379549449f / 16.0f)); const float rev_ = ang_ * 0.15915494f;
      rotx[r] = __builtin_amdgcn_fractf(rev_) + (__builtin_fmaf(ang_, 0.15915494f, -rev_) + ang_ * 6.4206383e-9f); }
    {
#define P2_DMA_Q(h, buf) do { int ll_ = lane; asm volatile("" : "+v"(ll_)); const int rl_ = 2 * wid + (ll_ >> 5), p_ = ll_ & 31, c_ = (p_ & 16) | ((p_ & 15) ^ (rl_ & 15)); const bf16* ls_ = Wt_uq + rl_ * QRANK + c_ * 8; \
        _Pragma("unroll") for (int i_ = 0; i_ < 6; ++i_) glds16(ls_ + (size_t)((h) * QKD + 16 * i_) * QRANK, (unsigned)__builtin_amdgcn_readfirstlane(lds0 + (buf) * WQ_BYTES + (wid + 8 * i_) * 1024)); } while (0)
      P2_WAIT_BAR();
      P2_DMA_Q(0, 0);
      bf16x8 bq[16];
#pragma unroll
      for (int k = 0; k < 16; ++k) bq[k] = *(const bf16x8*)(prow + C_CQ + 16 * k + 8 * hi);
      float sq = 0.f;
#pragma unroll
      for (int k = 0; k < 16; ++k) sq += sumsq8(bq[k]);
      sq = swap_add(sq);
      const float rq = __builtin_amdgcn_rsqf(sq * (1.f / QRANK) + EPS);
      unsigned char* stg = lds + A_STAGE + wid * A_STAGE_W;
      for (int h = 0; h < MH; ++h) {
        if (h == 0) { P2_WAIT_BAR(); } else { P2_WAIT_BAR_N(6); }
        if (h + 1 < MH) P2_DMA_Q(h + 1, (h + 1) & 1);
        const unsigned char* wb = lds + (h & 1) * WQ_BYTES;
        f32x16 acc[3] = {};
#pragma unroll
        for (int k = 0; k < 16; ++k)
#pragma unroll
          for (int t = 0; t < 3; ++t) { const int row = 32 * t + r32, c = 2 * k + hi; const bf16x8 af = *(const bf16x8*)(wb + row * 512 + (((c & 16) | ((c & 15) ^ (row & 15))) << 4));
            acc[t] = __builtin_amdgcn_mfma_f32_32x32x16_bf16(af, bq[k], acc[t], 0, 0, 0); }
        float ss = 0.f;
#pragma unroll
        for (int t = 0; t < 3; ++t)
#pragma unroll
          for (int r = 0; r < 16; ++r) ss += acc[t][r] * acc[t][r];
        ss = swap_add(ss);
        const float rr = ATT_C2 * rq * __builtin_amdgcn_rsqf(rq * rq * ss * (1.f / QKD) + EPS);
        unsigned char* srow = stg + r32 * QST;
#pragma unroll
        for (int t = 0; t < 2; ++t)
#pragma unroll
          for (int q4 = 0; q4 < 4; ++q4) { const int f0 = 32 * t + 8 * q4 + 4 * hi; const f32x4 g = *(const f32x4*)(gl + f0);
            *(v2u*)(srow + f0 * 2) = pk4(acc[t][4 * q4] * rr * g[0], acc[t][4 * q4 + 1] * rr * g[1], acc[t][4 * q4 + 2] * rr * g[2], acc[t][4 * q4 + 3] * rr * g[3]); }
        float y[16];
#pragma unroll
        for (int q4 = 0; q4 < 4; ++q4) { const f32x4 g = *(const f32x4*)(gl + 64 + 8 * q4 + 4 * hi);
#pragma unroll
          for (int e = 0; e < 4; ++e) y[4 * q4 + e] = acc[2][4 * q4 + e] * rr * g[e]; }
        float lo[8], up[8];
        {
#pragma unroll
        for (int r = 0; r < 8; ++r) { float x_ = rotx[r]; asm volatile("" : "+v"(x_));
          const float cs_ = __builtin_amdgcn_cosf(x_), sn_ = __builtin_amdgcn_sinf(x_);
          lo[r] = y[r] * cs_ - y[r + 8] * sn_; up[r] = y[r + 8] * cs_ + y[r] * sn_; } }
        *(v2u*)(srow + (64 + 4 * hi) * 2) = pk4(lo[0], lo[1], lo[2], lo[3]); *(v2u*)(srow + (72 + 4 * hi) * 2) = pk4(lo[4], lo[5], lo[6], lo[7]);
        *(v2u*)(srow + (80 + 4 * hi) * 2) = pk4(up[0], up[1], up[2], up[3]); *(v2u*)(srow + (88 + 4 * hi) * 2) = pk4(up[4], up[5], up[6], up[7]);
        bf16* qp = QM + ((size_t)(b * MH + h) * SEQ + s0) * QKD;
#pragma unroll
        for (int i = 0; i < 6; ++i) { int ll = lane; asm volatile("" : "+v"(ll)); const int idx = i * 64 + ll, row = (idx * 5462) >> 16, ch = idx - 12 * row; __builtin_nontemporal_store(*(const v4u*)(stg + row * QST + ch * 16), (v4u*)(qp + idx * 8)); }
      }
#undef P2_DMA_Q
    }
    {
#define P2_DMA_KV(h, buf) do { int ll_ = lane; asm volatile("" : "+v"(ll_)); const int rl_ = 4 * wid + (ll_ >> 4), c_ = (ll_ & 15) ^ (rl_ & 15); const bf16* ls_ = Wt_ukv + rl_ * KVRANK + c_ * 8; \
        _Pragma("unroll") for (int i_ = 0; i_ < 4; ++i_) glds16(ls_ + (size_t)((h) * 128 + 32 * i_) * KVRANK, (unsigned)__builtin_amdgcn_readfirstlane(lds0 + (buf) * WKV_BYTES + (wid + 8 * i_) * 1024)); } while (0)
      P2_WAIT_BAR_N(6);
      P2_DMA_KV(0, 0);
      bf16x8 bkv[8]; float krf[16];
#pragma unroll
      for (int k = 0; k < 8; ++k) bkv[k] = *(const bf16x8*)(prow + C_CKV + 16 * k + 8 * hi);
#pragma unroll
      for (int q4 = 0; q4 < 4; ++q4) { const v2u w = *(const v2u*)(prow + C_KR + 8 * q4 + 4 * hi); krf[4 * q4] = bflo(w.x); krf[4 * q4 + 1] = bfhi(w.x); krf[4 * q4 + 2] = bflo(w.y); krf[4 * q4 + 3] = bfhi(w.y); }
      float skv = 0.f, skr = 0.f;
#pragma unroll
      for (int k = 0; k < 8; ++k) skv += sumsq8(bkv[k]);
#pragma unroll
      for (int r = 0; r < 16; ++r) skr += krf[r] * krf[r];
      skv = swap_add(skv); skr = swap_add(skr);
      const float rkv = __builtin_amdgcn_rsqf(skv * (1.f / KVRANK) + EPS);
      unsigned char* stg = lds + B_STAGE + wid * B_STAGE_W; unsigned char* stv = stg + 32 * QST;
      for (int h = 0; h < MH; ++h) {
        if (h == 0) { P2_WAIT_BAR(); } else { P2_WAIT_BAR_N(10); }
        if (h + 1 < MH) P2_DMA_KV(h + 1, (h + 1) & 1);
        const unsigned char* wb = lds + (h & 1) * WKV_BYTES;
        f32x16 acc[4] = {};
#pragma unroll
        for (int k = 0; k < 8; ++k)
#pragma unroll
          for (int t = 0; t < 4; ++t) { const int row = 32 * t + r32, c = 2 * k + hi; const bf16x8 af = *(const bf16x8*)(wb + row * 256 + ((c ^ (row & 15)) << 4));
            acc[t] = __builtin_amdgcn_mfma_f32_32x32x16_bf16(af, bkv[k], acc[t], 0, 0, 0); }
        float ss = 0.f;
#pragma unroll
        for (int t = 0; t < 2; ++t)
#pragma unroll
          for (int r = 0; r < 16; ++r) ss += acc[t][r] * acc[t][r];
        ss = swap_add(ss);
        const float rk = __builtin_amdgcn_rsqf((rkv * rkv * ss + skr) * (1.f / QKD) + EPS), rr = rkv * rk;
        unsigned char* srow = stg + r32 * QST; unsigned char* vrow = stv + r32 * VST;
#pragma unroll
        for (int t = 0; t < 2; ++t)
#pragma unroll
          for (int q4 = 0; q4 < 4; ++q4) { const int f0 = 32 * t + 8 * q4 + 4 * hi; const f32x4 g = *(const f32x4*)(gl + 96 + f0);
            *(v2u*)(srow + f0 * 2) = pk4(acc[t][4 * q4] * rr * g[0], acc[t][4 * q4 + 1] * rr * g[1], acc[t][4 * q4 + 2] * rr * g[2], acc[t][4 * q4 + 3] * rr * g[3]);
            *(v2u*)(vrow + f0 * 2) = pk4(acc[2 + t][4 * q4] * rkv, acc[2 + t][4 * q4 + 1] * rkv, acc[2 + t][4 * q4 + 2] * rkv, acc[2 + t][4 * q4 + 3] * rkv); }
        float y[16];
#pragma unroll
        for (int q4 = 0; q4 < 4; ++q4) { const f32x4 g = *(const f32x4*)(gl + 96 + 64 + 8 * q4 + 4 * hi);
#pragma unroll
          for (int e = 0; e < 4; ++e) y[4 * q4 + e] = krf[4 * q4 + e] * rk * g[e]; }
        float lo[8], up[8];
        {
#pragma unroll
        for (int r = 0; r < 8; ++r) { float x_ = rotx[r]; asm volatile("" : "+v"(x_));
          const float cs_ = __builtin_amdgcn_cosf(x_), sn_ = __builtin_amdgcn_sinf(x_);
          lo[r] = y[r] * cs_ - y[r + 8] * sn_; up[r] = y[r + 8] * cs_ + y[r] * sn_; } }
        *(v2u*)(srow + (64 + 4 * hi) * 2) = pk4(lo[0], lo[1], lo[2], lo[3]); *(v2u*)(srow + (72 + 4 * hi) * 2) = pk4(lo[4], lo[5], lo[6], lo[7]);
        *(v2u*)(srow + (80 + 4 * hi) * 2) = pk4(up[0], up[1], up[2], up[3]); *(v2u*)(srow + (88 + 4 * hi) * 2) = pk4(up[4], up[5], up[6], up[7]);
        bf16* kp = KM + ((size_t)(b * MH + h) * SEQ + s0) * QKD; bf16* vp = VM + ((size_t)(b * MH + h) * SEQ + s0) * VD;
#pragma unroll
        for (int i = 0; i < 6; ++i) { int ll = lane; asm volatile("" : "+v"(ll)); const int idx = i * 64 + ll, row = (idx * 5462) >> 16, ch = idx - 12 * row; __builtin_nontemporal_store(*(const v4u*)(stg + row * QST + ch * 16), (v4u*)(kp + idx * 8)); }
#pragma unroll
        for (int i = 0; i < 4; ++i) { int ll = lane; asm volatile("" : "+v"(ll)); const int idx = i * 64 + ll, row = idx >> 3, ch = idx & 7; __builtin_nontemporal_store(*(const v4u*)(stv + row * VST + ch * 16), (v4u*)(vp + idx * 8)); }
      }
#undef P2_DMA_KV
    }
  }
  P2_WAIT_BAR();
}
#undef P2_WAIT_BAR
#undef P2_WAIT_BAR_N
}

namespace att {
using bf16x8 = __attribute__((ext_vector_type(8))) short;
using s16x4  = __attribute__((ext_vector_type(4))) short;
using f32x16 = __attribute__((ext_vector_type(16))) float;
using u32x4  = __attribute__((ext_vector_type(4))) unsigned;
constexpr int NW = 8, QBLK = 32, KVBLK = 64, DQK = 96, DV = 64;
constexpr float SCALE = 0.10206207261596577f;
constexpr float THR = 8.f;
constexpr int KROW = 208;
constexpr int SHM_K = KVBLK * KROW, SHM_V = KVBLK * DV * 2;
constexpr int L_V = 0, L_K = 2 * SHM_V, L_WS = L_K + 2 * SHM_K, L_OST = L_WS + NW * 64 * 4, L_BYTES = L_OST + NW * 4096;
#define ATT_SBAR() __builtin_amdgcn_sched_barrier(0)
__device__ __forceinline__ int crow(int r, int hi) { return (r & 3) + 8 * (r >> 2) + 4 * hi; }
__device__ __forceinline__ unsigned cvtpk(float lo, float hi) { unsigned r; asm volatile("v_cvt_pk_bf16_f32 %0, %1, %2" : "=v"(r) : "v"(lo), "v"(hi)); return r; }
__device__ __forceinline__ void partialSM(f32x16& p0, f32x16& p1, float& m_reg, float& mn, float& alpha) {
  constexpr float C = 1.0f;
  float pmax = p0[0];
#pragma unroll
  for (int r = 1; r < 16; ++r) pmax = fmaxf(pmax, p0[r]);
#pragma unroll
  for (int r = 0; r < 16; ++r) pmax = fmaxf(pmax, p1[r]);
  { auto rr = __builtin_amdgcn_permlane32_swap(__float_as_uint(pmax), __float_as_uint(pmax), false, false);
    pmax = fmaxf(__uint_as_float(rr[0]), __uint_as_float(rr[1])); }
  if (__builtin_expect(__all(pmax - m_reg <= THR * 1.4426950408889634f), 1)) { mn = m_reg; alpha = 1.f; }
  else { mn = fmaxf(m_reg, pmax); alpha = __builtin_amdgcn_exp2f((m_reg - mn) * C); m_reg = mn; }
  const float mnC = -mn * C;
#pragma unroll
  for (int r = 0; r < 16; ++r) p0[r] = fmaf(p0[r], C, mnC);
#pragma unroll
  for (int r = 0; r < 16; ++r) p1[r] = fmaf(p1[r], C, mnC);
#pragma unroll
  for (int r = 0; r < 16; ++r) p0[r] = __builtin_amdgcn_exp2f(p0[r]);
}
__device__ __forceinline__ void finishSM(f32x16& p0, f32x16& p1, float alpha, float& l_reg, bf16x8& pa0, bf16x8& pa1, bf16x8& pa2, bf16x8& pa3) {
#pragma unroll
  for (int r = 0; r < 16; ++r) p1[r] = __builtin_amdgcn_exp2f(p1[r]);
  float ps = 0;
#pragma unroll
  for (int r = 0; r < 16; ++r) ps += p0[r];
#pragma unroll
  for (int r = 0; r < 16; ++r) ps += p1[r];
  { auto rr = __builtin_amdgcn_permlane32_swap(__float_as_uint(ps), __float_as_uint(ps), false, false);
    ps = __uint_as_float(rr[0]) + __uint_as_float(rr[1]); }
  l_reg = l_reg * alpha + ps;
#define ATT_PK4(P, BASE, OUT) do { unsigned a0 = cvtpk(P[BASE + 0], P[BASE + 1]), a1 = cvtpk(P[BASE + 2], P[BASE + 3]);   \
    unsigned b0 = cvtpk(P[BASE + 4], P[BASE + 5]), b1 = cvtpk(P[BASE + 6], P[BASE + 7]);                              \
    auto r0 = __builtin_amdgcn_permlane32_swap(a0, b0, false, false); auto r1 = __builtin_amdgcn_permlane32_swap(a1, b1, false, false); \
    u32x4 w = {r0[0], r1[0], r0[1], r1[1]}; OUT = __builtin_bit_cast(bf16x8, w); } while (0)
  ATT_PK4(p0, 0, pa0); ATT_PK4(p0, 8, pa1); ATT_PK4(p1, 0, pa2); ATT_PK4(p1, 8, pa3);
#undef ATT_PK4
}
__device__ __forceinline__ void qkt(f32x16& p0, f32x16& p1, const char* Ks, const bf16x8* qr, int r32, int hi) {
  p0 = f32x16{}; p1 = f32x16{};
#pragma unroll
  for (int d0 = 0; d0 < 6; ++d0) { const int cb = (d0 * 16 + hi * 8) * 2;
    const bf16x8 b0 = *reinterpret_cast<const bf16x8*>(Ks + r32 * KROW + cb);
    const bf16x8 b1 = *reinterpret_cast<const bf16x8*>(Ks + (32 + r32) * KROW + cb);
    p0 = __builtin_amdgcn_mfma_f32_32x32x16_bf16(b0, qr[d0], p0, 0, 0, 0);
    p1 = __builtin_amdgcn_mfma_f32_32x32x16_bf16(b1, qr[d0], p1, 0, 0, 0); }
}
__device__ __forceinline__ int v_st(int k, int c) { const int kk = (k & ~0xC) | ((k & 4) << 1) | ((k & 8) >> 1); return ((kk >> 3) * 2 + (c >> 5)) * 512 + ((kk & 7) * 32 + (c & 31)) * 2; }
__device__ __forceinline__ int v_rd_base(int lane) { return ((lane & 3) << 3) | (((lane >> 2) & 3) << 6) | (((lane >> 4) & 1) << 5) | (((lane >> 5) & 1) << 8); }
constexpr int v_rd_off(int d0, int ks, int half) { return d0 * 512 + ks * 2048 + half * 1024; }
template <int OFF> __device__ __forceinline__ s16x4 tr_read(int vb) {
  s16x4 r; asm volatile("ds_read_b64_tr_b16 %0, %1 offset:%2" : "=&v"(r) : "v"(vb), "i"(OFF) : "memory"); return r;
}
template <int D0> __device__ __forceinline__ void pv_one(f32x16& od, int vb, bf16x8 pa0, bf16x8 pa1, bf16x8 pa2, bf16x8 pa3) {
  const s16x4 l0 = tr_read<v_rd_off(D0, 0, 0)>(vb), h0 = tr_read<v_rd_off(D0, 0, 1)>(vb), l1 = tr_read<v_rd_off(D0, 1, 0)>(vb), h1 = tr_read<v_rd_off(D0, 1, 1)>(vb);
  const s16x4 l2 = tr_read<v_rd_off(D0, 2, 0)>(vb), h2 = tr_read<v_rd_off(D0, 2, 1)>(vb), l3 = tr_read<v_rd_off(D0, 3, 0)>(vb), h3 = tr_read<v_rd_off(D0, 3, 1)>(vb);
  asm volatile("s_waitcnt lgkmcnt(0)" ::: "memory"); ATT_SBAR();
#define ATT_PK(L, H) (bf16x8){L[0], L[1], L[2], L[3], H[0], H[1], H[2], H[3]}
  od = __builtin_amdgcn_mfma_f32_32x32x16_bf16(pa0, ATT_PK(l0, h0), od, 0, 0, 0);
  od = __builtin_amdgcn_mfma_f32_32x32x16_bf16(pa1, ATT_PK(l1, h1), od, 0, 0, 0);
  od = __builtin_amdgcn_mfma_f32_32x32x16_bf16(pa2, ATT_PK(l2, h2), od, 0, 0, 0);
  od = __builtin_amdgcn_mfma_f32_32x32x16_bf16(pa3, ATT_PK(l3, h3), od, 0, 0, 0);
#undef ATT_PK
}
__device__ __forceinline__ void pv_d0(f32x16* o, int vb, bf16x8 pa0, bf16x8 pa1, bf16x8 pa2, bf16x8 pa3) {
  pv_one<0>(o[0], vb, pa0, pa1, pa2, pa3); pv_one<1>(o[1], vb, pa0, pa1, pa2, pa3);
}
__device__ __forceinline__ void attn_unit(const unsigned short* __restrict__ Qb, const unsigned short* __restrict__ Kh, const unsigned short* __restrict__ Vh, unsigned short* Ob, int ldo, int seq, char* lds) {
  int tid_ = threadIdx.x; asm volatile("" : "+v"(tid_));
  const int tid = tid_, wid = tid >> 6, lane = tid & 63, r32 = lane & 31, hi = lane >> 5;
  char* V_lds = lds + L_V; char* K_lds = lds + L_K;
  float* ws = (float*)(lds + L_WS) + wid * 64; float* li_l = ws; float* al_l = ws + 32;
  float m_reg = -1e30f, l_reg = 0; f32x16 o[2] = {}; bf16x8 qr[6];
  const unsigned short* Qw = Qb + (long)(wid * QBLK + r32) * DQK + hi * 8;
#pragma unroll
  for (int d0 = 0; d0 < 6; ++d0) qr[d0] = *reinterpret_cast<const bf16x8*>(Qw + d0 * 16);
  const int sr = tid >> 3, sc = (tid & 7) * 8, sr2 = tid >> 2, sc2 = 64 + (tid & 3) * 8; const bool two = tid < 256;
  const int vst = v_st(sr, sc), kst = sr * KROW + sc * 2, kst2 = sr2 * KROW + sc2 * 2;
  const int vb0 = (int)(uintptr_t)V_lds + v_rd_base(lane);
  struct { bf16x8 v, k, k2; } sg[2];
#define ATT_SLOAD(i, k0) do { sg[i].v = *reinterpret_cast<const bf16x8*>(&Vh[(long)((k0) + sr) * DV + sc]); sg[i].k = *reinterpret_cast<const bf16x8*>(&Kh[(long)((k0) + sr) * DQK + sc]); \
    if (two) sg[i].k2 = *reinterpret_cast<const bf16x8*>(&Kh[(long)((k0) + sr2) * DQK + sc2]); } while (0)
#define ATT_SWRITE(b, i) do { *(bf16x8*)(V_lds + (b) * SHM_V + vst) = sg[i].v; *(bf16x8*)(K_lds + (b) * SHM_K + kst) = sg[i].k; if (two) *(bf16x8*)(K_lds + (b) * SHM_K + kst2) = sg[i].k2; } while (0)
#define ATT_RESC(a) do { if (__any((a) < 1.f)) { if (hi == 0) al_l[r32] = (a); asm volatile("s_waitcnt lgkmcnt(0)" ::: "memory"); \
    _Pragma("unroll") for (int d = 0; d < 2; ++d) _Pragma("unroll") for (int r = 0; r < 16; ++r) o[d][r] *= al_l[crow(r, hi)]; } } while (0)
  f32x16 pA0, pA1, pB0, pB1; float mnA, mnB, alA, alB; bf16x8 pa0, pa1, pa2, pa3; const int NT = seq / KVBLK;
  ATT_SLOAD(0, 0); ATT_SWRITE(0, 0); __syncthreads();
  qkt(pA0, pA1, K_lds, qr, r32, hi); partialSM(pA0, pA1, m_reg, mnA, alA);
  ATT_SLOAD(1, KVBLK); ATT_SLOAD(0, 2 * KVBLK);
  ATT_SWRITE(1, 1); __syncthreads();
  for (int j = 1; j + 1 < NT; j += 2) {
    ATT_SBAR(); qkt(pB0, pB1, K_lds + SHM_K, qr, r32, hi);
    finishSM(pA0, pA1, alA, l_reg, pa0, pa1, pa2, pa3); ATT_SBAR();
    ATT_SLOAD(1, (j + 2) * KVBLK); ATT_SBAR();
    pv_d0(o, vb0, pa0, pa1, pa2, pa3); partialSM(pB0, pB1, m_reg, mnB, alB);
    __syncthreads(); ATT_SWRITE(0, 0);
    ATT_RESC(alB); __syncthreads();
    ATT_SBAR(); qkt(pA0, pA1, K_lds, qr, r32, hi);
    finishSM(pB0, pB1, alB, l_reg, pa0, pa1, pa2, pa3); ATT_SBAR();
    if (j + 3 < NT) ATT_SLOAD(0, (j + 3) * KVBLK); ATT_SBAR();
    pv_d0(o, vb0 + SHM_V, pa0, pa1, pa2, pa3); partialSM(pA0, pA1, m_reg, mnA, alA);
    __syncthreads(); ATT_SWRITE(1, 1);
    ATT_RESC(alA); __syncthreads();
  }
  ATT_SBAR(); qkt(pB0, pB1, K_lds + SHM_K, qr, r32, hi);
  finishSM(pA0, pA1, alA, l_reg, pa0, pa1, pa2, pa3); ATT_SBAR();
  pv_d0(o, vb0, pa0, pa1, pa2, pa3); partialSM(pB0, pB1, m_reg, mnB, alB);
  __syncthreads(); ATT_RESC(alB);
  finishSM(pB0, pB1, alB, l_reg, pa0, pa1, pa2, pa3); ATT_SBAR();
  pv_d0(o, vb0 + SHM_V, pa0, pa1, pa2, pa3);
  if (hi == 0) li_l[r32] = l_reg; asm volatile("s_waitcnt lgkmcnt(0)" ::: "memory");
  float rli[16];
#pragma unroll
  for (int r = 0; r < 16; ++r) rli[r] = __builtin_amdgcn_rcpf(li_l[crow(r, hi)]);
  { unsigned short* stg = (unsigned short*)(lds + L_OST) + wid * 2048;
#pragma unroll
    for (int r = 0; r < 16; ++r) { const int orow = crow(r, hi);
#pragma unroll
      for (int d0 = 0; d0 < 2; ++d0) stg[orow * 64 + d0 * 32 + r32] = (unsigned short)(cvtpk(o[d0][r] * rli[r], 0.f) & 0xffffu); }
    asm volatile("s_waitcnt lgkmcnt(0)" ::: "memory");
    unsigned short* Ow = Ob + (long)(wid * QBLK) * ldo;
#pragma unroll
    for (int i = 0; i < 4; ++i) { const int row = i * 8 + (lane >> 3), ch = lane & 7; const u32x4 v = *(const u32x4*)(stg + row * 64 + ch * 8); *(u32x4*)(Ow + (long)row * ldo + ch * 8) = v; } }
  __syncthreads();
#undef ATT_SLOAD
#undef ATT_SWRITE
#undef ATT_RESC
}
#undef ATT_SBAR
}


namespace att2 {
using bf16x8 = __attribute__((ext_vector_type(8))) short;
using s16x4  = __attribute__((ext_vector_type(4))) short;
using f32x16 = __attribute__((ext_vector_type(16))) float;
using u32x4  = __attribute__((ext_vector_type(4))) unsigned;
constexpr int NW = 8, QBLK = 32, KVBLK = 64, DQK = 96, DV = 64, NT = SEQ / KVBLK;
constexpr int NSLOT = 3, KNSLOT = 4, KSLOT = 12288, VSLOT = 8192;
constexpr int LDS_K = 0, LDS_V = KNSLOT * KSLOT, LDS_WS = LDS_V + NSLOT * VSLOT, LDS_OST = LDS_WS + NW * 64 * 4, LDS_BYTES_ = LDS_OST + NW * 4096;
__device__ __forceinline__ int crow(int r, int hi) { return (r & 3) + 8 * (r >> 2) + 4 * hi; }
#define A2_SBAR() __builtin_amdgcn_sched_barrier(0)
__device__ __forceinline__ void glds16s(const void* sbase, unsigned voff, unsigned lds_dst) {
  asm volatile("s_mov_b32 m0, %2\n\ts_nop 0\n\tglobal_load_lds_dwordx4 %0, %1" :: "v"(voff), "s"(sbase), "s"(lds_dst) : "memory", "m0"); }
__device__ __forceinline__ void glds16(const void* gsrc, unsigned lds_dst) { unsigned keep;
  asm volatile("s_mov_b32 %0, m0\n\ts_mov_b32 m0, %2\n\ts_nop 0\n\tglobal_load_lds_dwordx4 %1, off\n\ts_mov_b32 m0, %0" : "=&s"(keep) : "v"(gsrc), "s"(lds_dst) : "memory"); }
typedef float f32x2_t __attribute__((ext_vector_type(2))); typedef __bf16 bf16x2_t __attribute__((ext_vector_type(2)));
__device__ __forceinline__ unsigned cvtpk_s(float lo, float hi) { f32x2_t v = {lo, hi}; bf16x2_t b = __builtin_convertvector(v, bf16x2_t); return __builtin_bit_cast(unsigned, b); }
#define A2_WAIT_BAR(N) asm volatile("s_waitcnt vmcnt(" #N ") lgkmcnt(0)\n\ts_barrier" ::: "memory")
#define A2_WAITB(N4, N8) do { if (lo4) { A2_WAIT_BAR(N4); } else { A2_WAIT_BAR(N8); } } while (0)
typedef __attribute__((address_space(3))) const char* lds_cptr;
typedef short v4i16_t __attribute__((ext_vector_type(4)));
__device__ __forceinline__ void kload2(bf16x8* kf, lds_cptr kp, int j) { kf[2 * j] = *(const __attribute__((address_space(3))) bf16x8*)(kp + j * 2048); kf[2 * j + 1] = *(const __attribute__((address_space(3))) bf16x8*)(kp + j * 2048 + 512); }
__device__ __forceinline__ s16x4 vtr(lds_cptr p) { return __builtin_bit_cast(s16x4, __builtin_amdgcn_ds_read_tr16_b64_v4i16((__attribute__((address_space(3))) v4i16_t*)p)); }

__device__ __forceinline__ void attn_unit(const unsigned short* Qb, const unsigned short* __restrict__ Kh, const unsigned short* __restrict__ Vh, unsigned short* Ob, int ldo, char* shm) {
  int tid_ = threadIdx.x; asm volatile("" : "+v"(tid_));
  const int tid = tid_, lane = tid & 63, r32 = lane & 31, hi = lane >> 5; const int wid = __builtin_amdgcn_readfirstlane(tid >> 6); const bool lo4 = wid < 4;
  const unsigned lds0 = (unsigned)(uintptr_t)shm;
  float* wsf = (float*)(shm + LDS_WS) + wid * 64;
  const unsigned koff = (unsigned)((lane * DQK + wid * 8) * 2), koff2 = (unsigned)((lane * DQK + (8 + (wid & 3)) * 8) * 2);
  const unsigned voff = (unsigned)(((16 * (wid & 3) + (lane >> 2)) * DV + (wid >> 2) * 32 + (lane & 3) * 8) * 2);
  const unsigned kdst = lds0 + LDS_K + wid * 1024, kdst2 = lds0 + LDS_K + (8 + (wid & 3)) * 1024, vdst = lds0 + LDS_V + wid * 1024;
#define A2_DMA_K(t, slot) do { const unsigned short* kb_ = Kh + (long)(t) * KVBLK * DQK; glds16s(kb_, koff, (unsigned)__builtin_amdgcn_readfirstlane(kdst + (slot) * KSLOT)); \
    if (lo4) glds16s(kb_, koff2, (unsigned)__builtin_amdgcn_readfirstlane(kdst2 + (slot) * KSLOT)); } while (0)
#define A2_DMA_V(t, slot) glds16s(Vh + (long)(t) * KVBLK * DV, voff, (unsigned)__builtin_amdgcn_readfirstlane(vdst + (slot) * VSLOT))
  const lds_cptr shm3 = (lds_cptr)shm; const lds_cptr kp0 = shm3 + LDS_K + hi * 1024 + r32 * 16;
  const lds_cptr vp0 = shm3 + LDS_V + ((lane >> 4) & 1) * 32 + (lane & 3) * 8 + (4 * hi + ((lane & 15) >> 2)) * 64;
  bf16x8 kf[12];
  A2_DMA_K(0, 0); A2_DMA_V(0, 0); A2_DMA_K(1, 1);
  bf16x8 qr[6];
  { const unsigned short* Qw = Qb + (long)(wid * QBLK + r32) * DQK + hi * 8;
#pragma unroll
    for (int d0 = 0; d0 < 6; ++d0) qr[d0] = *reinterpret_cast<const bf16x8*>(Qw + d0 * 16); }
  float l_reg = 0.f; f32x16 o[2]; o[0] = f32x16{}; o[1] = f32x16{};
  f32x16 pA0, pA1, pB0, pB1;
  int sl_prev = 0, sl_cur = 0, sl_next = 1;
  int kq1 = 1, kq3 = 3;
  const bool late = !lo4;
#define A2_ROT() do { sl_prev = sl_cur; sl_cur = sl_next; sl_next = (sl_next == NSLOT - 1) ? 0 : sl_next + 1; kq1 = (kq1 + 1) & 3; kq3 = (kq3 + 1) & 3; } while (0)
  A2_DMA_K(2, 2);
  A2_WAITB(5, 3);
  { pA0 = f32x16{}; pA1 = f32x16{};
#pragma unroll
    for (int d0 = 0; d0 < 6; ++d0) { const bf16x8 b0 = *(const __attribute__((address_space(3))) bf16x8*)(kp0 + d0 * 2048), b1 = *(const __attribute__((address_space(3))) bf16x8*)(kp0 + d0 * 2048 + 512);
      pA0 = __builtin_amdgcn_mfma_f32_32x32x16_bf16(b0, qr[d0], pA0, 0, 0, 0); pA1 = __builtin_amdgcn_mfma_f32_32x32x16_bf16(b1, qr[d0], pA1, 0, 0, 0); }
#pragma unroll
    for (int r = 0; r < 16; ++r) { pA0[r] = __builtin_amdgcn_exp2f(pA0[r]); pA1[r] = __builtin_amdgcn_exp2f(pA1[r]); } }
  A2_WAIT_BAR(0);
  A2_DMA_K(3, 3); A2_DMA_V(1, 1);
  A2_ROT();
  { const lds_cptr kp = kp0 + 1 * KSLOT;
#pragma unroll
    for (int j = 0; j < 6; ++j) kload2(kf, kp, j); }
  A2_WAITB(3, 2);
  s16x4 vlo[8], vhi[8]; u32x4 pw0, pw1, pw2, pw3;
#define A2_PKW(P, B) cvtpk_s(P[B], P[B + 1])
#define A2_PAF(k) __builtin_bit_cast(bf16x8, pw##k)
#define A2_VFR(i) (bf16x8){vlo[i][0], vlo[i][1], vlo[i][2], vlo[i][3], vhi[i][0], vhi[i][1], vhi[i][2], vhi[i][3]}
#define A2_PIN(x) asm volatile("" : "+v"(x))
#define A2_EX(v) __builtin_amdgcn_exp2f(v)
#define A2_VRD(i) do { vlo[i] = vtr(vp_ + (((i) >> 2) * 4096 + ((i) & 3) * 1024)); vhi[i] = vtr(vp_ + (((i) >> 2) * 4096 + ((i) & 3) * 1024 + 512)); } while (0)
#define A2_KRD(G, j) do { if (G) { kload2(kf, kp0 + kq1 * KSLOT, j); A2_SBAR(); } } while (0)
#define A2_GA3(MF, X0, X1, X2) do { MF; sacc += X0; sacc += X1; sacc += X2; A2_PIN(sacc); } while (0)
#define A2_GAPB(MF, X, B) do { MF; X[B] = A2_EX(X[B]); X[B + 1] = A2_EX(X[B + 1]); X[B + 2] = A2_EX(X[B + 2]); X[B + 3] = A2_EX(X[B + 3]); A2_PIN(X); A2_SBAR(); } while (0)
#define A2_MF(C, i, first) C = __builtin_amdgcn_mfma_f32_32x32x16_bf16(kf[i], qr[(i) >> 1], (first) ? f32x16{} : C, 0, 0, 0)
#define A2_STEP(C0, C1, P0, P1, t, GK, GV, GL, W) do { A2_SBAR(); \
    const lds_cptr vp_ = vp0 + sl_prev * VSLOT; \
    float sacc = (P0[0] + P0[1]); \
    A2_VRD(0); A2_SBAR(); A2_GA3(A2_MF(C0, 0, true),  P0[2],  P0[3],  P0[4]);  pw0[0] = A2_PKW(P0, 0);  A2_PIN(pw0); A2_SBAR(); \
    A2_VRD(4); A2_SBAR(); A2_GA3(A2_MF(C1, 1, true),  P0[5],  P0[6],  P0[7]);  pw0[1] = A2_PKW(P0, 2);  A2_PIN(pw0); A2_SBAR(); \
    A2_VRD(1); A2_SBAR(); A2_GA3(A2_MF(C0, 2, false), P0[8],  P0[9],  P0[10]); pw0[2] = A2_PKW(P0, 4);  A2_PIN(pw0); A2_SBAR(); \
    A2_VRD(5); A2_SBAR(); A2_GA3(A2_MF(C1, 3, false), P0[11], P0[12], P0[13]); pw0[3] = A2_PKW(P0, 6);  A2_PIN(pw0); A2_SBAR(); \
    A2_VRD(2); A2_SBAR(); A2_GA3(A2_MF(C0, 4, false), P0[14], P0[15], P1[0]);  pw1[0] = A2_PKW(P0, 8);  A2_PIN(pw1); A2_SBAR(); \
    A2_VRD(6); A2_SBAR(); A2_GA3(A2_MF(C1, 5, false), P1[1],  P1[2],  P1[3]);  pw1[1] = A2_PKW(P0, 10); A2_PIN(pw1); A2_SBAR(); \
    A2_VRD(3); A2_SBAR(); A2_GA3(A2_MF(C0, 6, false), P1[4],  P1[5],  P1[6]);  pw1[2] = A2_PKW(P0, 12); A2_PIN(pw1); A2_SBAR(); \
    A2_VRD(7); A2_SBAR(); A2_GA3(A2_MF(C1, 7, false), P1[7],  P1[8],  P1[9]);  pw1[3] = A2_PKW(P0, 14); A2_PIN(pw1); A2_SBAR(); \
    A2_GA3(A2_MF(C0, 8, false),  P1[10], P1[11], P1[12]); pw2[0] = A2_PKW(P1, 0);  pw2[1] = A2_PKW(P1, 2);  A2_PIN(pw2); A2_SBAR(); \
    A2_GA3(A2_MF(C1, 9, false),  P1[13], P1[14], P1[15]); pw2[2] = A2_PKW(P1, 4);  pw2[3] = A2_PKW(P1, 6);  A2_PIN(pw2); A2_SBAR(); \
    A2_MF(C0, 10, false); pw3[0] = A2_PKW(P1, 8);  pw3[1] = A2_PKW(P1, 10); A2_PIN(pw3); A2_SBAR(); \
    A2_MF(C1, 11, false); pw3[2] = A2_PKW(P1, 12); pw3[3] = A2_PKW(P1, 14); A2_PIN(pw3); A2_SBAR(); \
    l_reg += sacc; \
    if (GK) { A2_DMA_K((t) + 3, kq3); } if (GV) { A2_DMA_V((t) + 1, sl_next); } \
    if (late) { W; } \
    A2_SBAR(); \
    A2_GAPB(o[0] = __builtin_amdgcn_mfma_f32_32x32x16_bf16(A2_PAF(0), A2_VFR(0), o[0], 0, 0, 0), C0, 0); \
    A2_KRD(GL, 0); A2_GAPB(o[1] = __builtin_amdgcn_mfma_f32_32x32x16_bf16(A2_PAF(0), A2_VFR(4), o[1], 0, 0, 0), C0, 4); \
    A2_KRD(GL, 1); A2_GAPB(o[0] = __builtin_amdgcn_mfma_f32_32x32x16_bf16(A2_PAF(1), A2_VFR(1), o[0], 0, 0, 0), C0, 8); \
    A2_KRD(GL, 2); A2_GAPB(o[1] = __builtin_amdgcn_mfma_f32_32x32x16_bf16(A2_PAF(1), A2_VFR(5), o[1], 0, 0, 0), C0, 12); \
    A2_KRD(GL, 3); A2_GAPB(o[0] = __builtin_amdgcn_mfma_f32_32x32x16_bf16(A2_PAF(2), A2_VFR(2), o[0], 0, 0, 0), C1, 0); \
    A2_KRD(GL, 4); A2_GAPB(o[1] = __builtin_amdgcn_mfma_f32_32x32x16_bf16(A2_PAF(2), A2_VFR(6), o[1], 0, 0, 0), C1, 4); \
    A2_KRD(GL, 5); A2_GAPB(o[0] = __builtin_amdgcn_mfma_f32_32x32x16_bf16(A2_PAF(3), A2_VFR(3), o[0], 0, 0, 0), C1, 8); \
    A2_GAPB(o[1] = __builtin_amdgcn_mfma_f32_32x32x16_bf16(A2_PAF(3), A2_VFR(7), o[1], 0, 0, 0), C1, 12); \
  } while (0)
  int t = 1;
  for (; t + 5 < NT; t += 2) {
    A2_STEP(pB0, pB1, pA0, pA1, t, true, true, true, A2_WAITB(3, 2));     if (!late) { A2_WAITB(3, 2); } A2_ROT();
    A2_STEP(pA0, pA1, pB0, pB1, t + 1, true, true, true, A2_WAITB(3, 2)); if (!late) { A2_WAITB(3, 2); } A2_ROT();
  }
#define A2_ENDW(tt) do { if ((tt) + 3 < NT) { A2_WAITB(3, 2); } else if ((tt) + 2 < NT) { A2_WAIT_BAR(1); } else { A2_WAIT_BAR(0); } } while (0)
  for (; t + 1 < NT; t += 2) {
    A2_STEP(pB0, pB1, pA0, pA1, t, (t + 3 < NT), (t + 1 < NT), (t + 1 < NT), A2_ENDW(t));             if (!late) { A2_ENDW(t); }     A2_ROT();
    A2_STEP(pA0, pA1, pB0, pB1, t + 1, (t + 4 < NT), (t + 2 < NT), (t + 2 < NT), A2_ENDW(t + 1));     if (!late) { A2_ENDW(t + 1); } A2_ROT();
  }
  A2_STEP(pB0, pB1, pA0, pA1, NT - 1, false, false, false, (void)0);
  { float sacc = pB0[0] + pB0[1];
#pragma unroll
    for (int r = 2; r < 16; ++r) sacc += pB0[r];
#pragma unroll
    for (int r = 0; r < 16; ++r) sacc += pB1[r];
    l_reg += sacc;
    pw0 = (u32x4){A2_PKW(pB0, 0), A2_PKW(pB0, 2), A2_PKW(pB0, 4), A2_PKW(pB0, 6)}; pw1 = (u32x4){A2_PKW(pB0, 8), A2_PKW(pB0, 10), A2_PKW(pB0, 12), A2_PKW(pB0, 14)};
    pw2 = (u32x4){A2_PKW(pB1, 0), A2_PKW(pB1, 2), A2_PKW(pB1, 4), A2_PKW(pB1, 6)}; pw3 = (u32x4){A2_PKW(pB1, 8), A2_PKW(pB1, 10), A2_PKW(pB1, 12), A2_PKW(pB1, 14)};
    A2_SBAR();
    const lds_cptr vp_ = vp0 + sl_cur * VSLOT;
#pragma unroll
    for (int i = 0; i < 8; ++i) A2_VRD(i);
    o[0] = __builtin_amdgcn_mfma_f32_32x32x16_bf16(A2_PAF(0), A2_VFR(0), o[0], 0, 0, 0); o[1] = __builtin_amdgcn_mfma_f32_32x32x16_bf16(A2_PAF(0), A2_VFR(4), o[1], 0, 0, 0);
    o[0] = __builtin_amdgcn_mfma_f32_32x32x16_bf16(A2_PAF(1), A2_VFR(1), o[0], 0, 0, 0); o[1] = __builtin_amdgcn_mfma_f32_32x32x16_bf16(A2_PAF(1), A2_VFR(5), o[1], 0, 0, 0);
    o[0] = __builtin_amdgcn_mfma_f32_32x32x16_bf16(A2_PAF(2), A2_VFR(2), o[0], 0, 0, 0); o[1] = __builtin_amdgcn_mfma_f32_32x32x16_bf16(A2_PAF(2), A2_VFR(6), o[1], 0, 0, 0);
    o[0] = __builtin_amdgcn_mfma_f32_32x32x16_bf16(A2_PAF(3), A2_VFR(3), o[0], 0, 0, 0); o[1] = __builtin_amdgcn_mfma_f32_32x32x16_bf16(A2_PAF(3), A2_VFR(7), o[1], 0, 0, 0); }
  { auto rr = __builtin_amdgcn_permlane32_swap(__float_as_uint(l_reg), __float_as_uint(l_reg), false, false); l_reg = __uint_as_float(rr[0]) + __uint_as_float(rr[1]); }
  if (hi == 0) wsf[32 + r32] = l_reg;
  asm volatile("s_waitcnt lgkmcnt(0)" ::: "memory");
  float rli[16];
#pragma unroll
  for (int r = 0; r < 16; ++r) rli[r] = __builtin_amdgcn_rcpf(wsf[32 + crow(r, hi)]);
  { unsigned short* stg = (unsigned short*)(shm + LDS_OST) + wid * 2048;
#pragma unroll
    for (int r = 0; r < 16; ++r) { const int orow = crow(r, hi);
#pragma unroll
      for (int d0 = 0; d0 < 2; ++d0) stg[orow * 64 + d0 * 32 + r32] = (unsigned short)(cvtpk_s(o[d0][r] * rli[r], 0.f) & 0xffffu); }
    asm volatile("s_waitcnt lgkmcnt(0)" ::: "memory");
    unsigned short* Ow = Ob + (long)(wid * QBLK) * ldo;
#pragma unroll
    for (int i = 0; i < 4; ++i) { const int row = i * 8 + (lane >> 3), ch = lane & 7; const u32x4 v = *(const u32x4*)(stg + row * 64 + ch * 8); *(u32x4*)(Ow + (long)row * ldo + ch * 8) = v; } }
  asm volatile("s_waitcnt lgkmcnt(0)\n\ts_barrier" ::: "memory");
#undef A2_DMA_K
#undef A2_DMA_V
#undef A2_ROT
#undef A2_PKW
#undef A2_PAF
#undef A2_VFR
#undef A2_PIN
#undef A2_EX
#undef A2_VRD
#undef A2_KRD
#undef A2_GA3
#undef A2_GAPB
#undef A2_MF
#undef A2_STEP
#undef A2_ENDW
}
#undef A2_SBAR
#undef A2_WAIT_BAR
#undef A2_WAITB
}

__device__ __forceinline__ void p3_attn(const Args& a, unsigned char* lds, int bid, int G) {
    unsigned char* ws = a.ws;
    const bf16* QM = (const bf16*)(ws + WS_QM); const bf16* KM = (const bf16*)(ws + WS_KM); const bf16* VM = (const bf16*)(ws + WS_VM); bf16* MIX = (bf16*)(ws + WS_MIX);
    const int vcu = (G % 8 == 0) ? (bid % 8) * (G / 8) + bid / 8 : bid;
    float gq = 0.f, gk = 0.f;
    for (int i = 0; i < QKD; ++i) { gq = fmaxf(gq, fabsf(a.qng[i])); gk = fmaxf(gk, fabsf(a.kng[i])); }
    const bool fast = (float)QKD * gq * gk * ATT_C2 * 1.05f < 64.0f;
    for (int u = vcu; u < BH * (SEQ / 256); u += G) {
        const int bh = u / (SEQ / 256), qb = u % (SEQ / 256), b = bh / MH, h = bh % MH;
        if (fast) att2::attn_unit(QM + ((size_t)bh * SEQ + qb * 256) * QKD, KM + (size_t)bh * SEQ * QKD, VM + (size_t)bh * SEQ * VD, MIX + ((size_t)b * SEQ + qb * 256) * DM + RW + h * VD, DM, (char*)lds);
        else att::attn_unit(QM + ((size_t)bh * SEQ + qb * 256) * QKD, KM + (size_t)bh * SEQ * QKD, VM + (size_t)bh * SEQ * VD, MIX + ((size_t)b * SEQ + qb * 256) * DM + RW + h * VD, DM, SEQ, (char*)lds);
    }
}

namespace ret {
using bf16x8 = __attribute__((ext_vector_type(8))) short;
using s16x4  = __attribute__((ext_vector_type(4))) short;
using f32x4v = __attribute__((ext_vector_type(4))) float;
typedef short v4i16_t __attribute__((ext_vector_type(4)));
constexpr int L_Q = 0, L_K = 16384, L_V = 32768, L_SF = 49152, L_SB = 57344, L_ZF = 65536, L_ZB = 66048, L_DEC = 66560  , L_BYTES = 66560 + 65536;
constexpr int NSTEP = 47;
#define RET_BAR() asm volatile("s_waitcnt lgkmcnt(0)\n\ts_barrier" ::: "memory")
__device__ __forceinline__ int fsw(int m) { return ((m >> 2) & 1) | (((m >> 1) & 1) << 1) | ((((m >> 2) ^ (m >> 3)) & 1) << 2); }
__device__ __forceinline__ int sw(int m, int d) { return m * 128 + (((d >> 3) ^ fsw(m)) << 4) + (d & 7) * 2; }
__device__ __forceinline__ s16x4 trd(const unsigned char* p) { return __builtin_bit_cast(s16x4, __builtin_amdgcn_ds_read_tr16_b64_v4i16((LAS v4i16_t*)(p))); }
__device__ __forceinline__ bf16x8 cat8(s16x4 lo, s16x4 hi) { return (bf16x8){lo[0], lo[1], lo[2], lo[3], hi[0], hi[1], hi[2], hi[3]}; }
typedef float f32x2_t __attribute__((ext_vector_type(2))); typedef __bf16 bf16x2_t __attribute__((ext_vector_type(2)));
__device__ __forceinline__ unsigned cvt2(float lo, float hi) { f32x2_t v = {lo, hi}; bf16x2_t b = __builtin_convertvector(v, bf16x2_t); return __builtin_bit_cast(unsigned, b); }
__device__ __forceinline__ f32x4v mma(bf16x8 a_, bf16x8 b_, f32x4v c_) { return __builtin_amdgcn_mfma_f32_16x16x32_bf16(a_, b_, c_, 0, 0, 0); }
__device__ __forceinline__ void step_info(int k, int half, int& type, int& ch) {
  if (k < 31) { if (half == 0 || k < 15) { type = 0; ch = 31 - k; } else { type = 1; ch = k - 15; } }
  else { type = 2; ch = (k - 31) + 16 * half; }
}
__device__ __forceinline__ void kv_update(f32x4v (&acc)[2], const unsigned char* lds, const float* zt, int v, int u0, int g, int q, int p) {
  s16x4 alo[4], ahi[4], blo[4][2], bhi[4][2]; f32x4v z0[4], z1[4];
#pragma unroll
  for (int s = 0; s < 4; ++s) { const int mb = 32 * s + 8 * g;
    alo[s] = trd(lds + L_K + sw(mb + q, 16 * v + 4 * p)); ahi[s] = trd(lds + L_K + sw(mb + 4 + q, 16 * v + 4 * p));
    z0[s] = *(const f32x4v*)(zt + mb); z1[s] = *(const f32x4v*)(zt + mb + 4);
#pragma unroll
    for (int uu = 0; uu < 2; ++uu) { blo[s][uu] = trd(lds + L_V + sw(mb + q, 16 * (u0 + uu) + 4 * p)); bhi[s][uu] = trd(lds + L_V + sw(mb + 4 + q, 16 * (u0 + uu) + 4 * p)); } }
  __builtin_amdgcn_sched_barrier(0);
#pragma unroll
  for (int s = 0; s < 4; ++s) {
    v4u w; w.x = cvt2(bf2f((unsigned short)alo[s][0]) * z0[s][0], bf2f((unsigned short)alo[s][1]) * z0[s][1]); w.y = cvt2(bf2f((unsigned short)alo[s][2]) * z0[s][2], bf2f((unsigned short)alo[s][3]) * z0[s][3]);
    w.z = cvt2(bf2f((unsigned short)ahi[s][0]) * z1[s][0], bf2f((unsigned short)ahi[s][1]) * z1[s][1]); w.w = cvt2(bf2f((unsigned short)ahi[s][2]) * z1[s][2], bf2f((unsigned short)ahi[s][3]) * z1[s][3]);
    const bf16x8 az = __builtin_bit_cast(bf16x8, w);
#pragma unroll
    for (int uu = 0; uu < 2; ++uu) acc[uu] = mma(az, cat8(blo[s][uu], bhi[s][uu]), acc[uu]); }
}
__device__ __forceinline__ void item(const Args& a, unsigned char* lds, int it) {
  int tid_ = threadIdx.x; asm volatile("" : "+v"(tid_));
  const int tid = tid_, wid = tid >> 6, lane = tid & 63, l15 = lane & 15, g = lane >> 4, q = (lane >> 2) & 3, p = lane & 3;
  const int bh = it >> 1, half = it & 1, b = bh / RH, h = bh % RH;
  unsigned char* ws = a.ws;
  const bf16* pb = (const bf16*)(ws + WS_PROJ) + (size_t)b * SEQ * NINP + h * RD; bf16* MIX = (bf16*)(ws + WS_MIX) + (size_t)b * SEQ * DM + h * RD;
  unsigned char* RB = ws + WS_RB + (size_t)it * (16 * 8192);
  const float lgf = ((const float*)(ws + WS_LG))[h], lgb = ((const float*)(ws + WS_LG))[RH + h];
  float* zf = (float*)(lds + L_ZF); float* zb = (float*)(lds + L_ZB);
  __syncthreads();
  if (tid < 128) zf[tid] = exp2f(lgf * (float)(127 - tid)); else if (tid < 256) zb[tid - 128] = exp2f(lgb * (float)(tid - 128));
  if (half == 1) { const v4u z = {0u, 0u, 0u, 0u}; ((v4u*)(RB + 15 * 8192))[tid] = z; }
  const float dec_f = exp2f(lgf * 128.f), dec_b = exp2f(lgb * 128.f);
  float rf[4], rb[4];
#pragma unroll
  for (int r4 = 0; r4 < 4; ++r4) { rf[r4] = exp2f(-lgf * (float)r4); rb[r4] = exp2f(lgb * (float)r4); }
  const int v = wid >> 1, u0 = 2 * (wid & 1);
  f32x4v sf[2] = {}, sb[2] = {};
  const int srow = tid >> 3, sc = tid & 7;
  const int lw0 = sw(srow, 8 * sc), lw1 = sw(srow + 64, 8 * sc);
#define RET_ISSUE_L(ld, kk) do { int ty_, ch_; step_info((kk), half, ty_, ch_); const bf16* r0_ = pb + (size_t)(ch_ * RCH + srow) * NINP + sc * 8; const bf16* r1_ = r0_ + (size_t)64 * NINP; \
    ld[0] = *(const v4u*)(r0_ + C_K); ld[1] = *(const v4u*)(r1_ + C_K); ld[2] = *(const v4u*)(r0_ + C_V); ld[3] = *(const v4u*)(r1_ + C_V); } while (0)
#define RET_ISSUE_H(ld, kk) do { int ty_, ch_; step_info((kk), half, ty_, ch_); const bf16* r0_ = pb + (size_t)(ch_ * RCH + srow) * NINP + sc * 8; const bf16* r1_ = r0_ + (size_t)64 * NINP; \
    ld[0] = *(const v4u*)(r0_ + C_Q); ld[1] = *(const v4u*)(r1_ + C_Q); ld[2] = *(const v4u*)(r0_ + C_K); ld[3] = *(const v4u*)(r1_ + C_K); ld[4] = *(const v4u*)(r0_ + C_V); ld[5] = *(const v4u*)(r1_ + C_V); \
    if ((kk) > 31) ld[6] = *(const v4u*)(RB + (size_t)(ch_ - 16 * half) * 8192 + tid * 16); } while (0)
  v4u ldH[7];
  { v4u ldA[4], ldB[4];
    RET_ISSUE_L(ldA, 0); RET_ISSUE_L(ldB, 1);
    auto light = [&](const int k, v4u (&ld)[4]) __attribute__((always_inline)) {
      int type, ch; step_info(k, half, type, ch);
      *(v4u*)(lds + L_K + lw0) = ld[0]; *(v4u*)(lds + L_K + lw1) = ld[1]; *(v4u*)(lds + L_V + lw0) = ld[2]; *(v4u*)(lds + L_V + lw1) = ld[3];
      RET_BAR();
      if (k + 2 < 31) RET_ISSUE_L(ld, k + 2);
      if (k == 29) RET_ISSUE_H(ldH, 31);
      if (type == 0) { sb[0] *= dec_b; sb[1] *= dec_b; kv_update(sb, lds, zb, v, u0, g, q, p);
        const int slot = ch - 1 - 16 * half;
        if (slot >= 0 && slot < 16) {
#pragma unroll
          for (int uu = 0; uu < 2; ++uu) { v2u w; w.x = cvt2(sb[uu][0], sb[uu][1]); w.y = cvt2(sb[uu][2], sb[uu][3]); *(v2u*)(RB + (size_t)slot * 8192 + ((16 * (u0 + uu) + l15) * 64 + 16 * v + 4 * g) * 2) = w; } } }
      else { sf[0] *= dec_f; sf[1] *= dec_f; kv_update(sf, lds, zf, v, u0, g, q, p); }
      RET_BAR();
    };
    for (int k = 0; k + 1 < 31; k += 2) { light(k, ldA); light(k + 1, ldB); }
    light(30, ldA); }
  __syncthreads();
  { const int n_ = 16 * wid + l15;
#pragma unroll
    for (int t = 0; t < 8; ++t) { const float ft = __builtin_amdgcn_exp2f(lgf * (float)(n_ - 4 * g - 16 * t)), bt = __builtin_amdgcn_exp2f(lgb * (float)(16 * t + 4 * g - n_)); f32x4v fv;
#pragma unroll
      for (int r4 = 0; r4 < 4; ++r4) fv[r4] = (16 * t + 4 * g + r4 <= n_) ? ft * rf[r4] : bt * rb[r4];
      *(f32x4v*)(lds + L_DEC + (t * 512 + tid) * 16) = fv; } }
  for (int k = 31; k < NSTEP; ++k) {
    int type, ch; step_info(k, half, type, ch);
    { *(v4u*)(lds + L_Q + lw0) = ldH[0]; *(v4u*)(lds + L_Q + lw1) = ldH[1];
      const v4u rb = (k > 31) ? ldH[6] : *(const v4u*)(RB + (size_t)(ch - 16 * half) * 8192 + tid * 16); *(v4u*)(lds + L_SB + lw0) = rb;
#pragma unroll
      for (int uu = 0; uu < 2; ++uu) { v2u w; w.x = cvt2(sf[uu][0], sf[uu][1]); w.y = cvt2(sf[uu][2], sf[uu][3]); *(v2u*)(lds + L_SF + sw(16 * (u0 + uu) + l15, 16 * v + 4 * g)) = w; } }
    *(v4u*)(lds + L_K + lw0) = ldH[2]; *(v4u*)(lds + L_K + lw1) = ldH[3]; *(v4u*)(lds + L_V + lw0) = ldH[4]; *(v4u*)(lds + L_V + lw1) = ldH[5];
    RET_BAR();
    if (k + 1 < NSTEP) RET_ISSUE_H(ldH, k + 1);
    {
      const int n = 16 * wid + l15;
      bf16x8 qf[2];
#pragma unroll
      for (int s = 0; s < 2; ++s) qf[s] = *(const bf16x8*)(lds + L_Q + sw(n, 32 * s + 8 * g));
      const int tok = ch * RCH + n; const bf16* gp = pb + (size_t)tok * NINP + C_G + 4 * g; v2u gwv[4];
#pragma unroll
      for (int u = 0; u < 4; ++u) gwv[u] = *(const v2u*)(gp + 16 * u);
      f32x4v st[8];
#pragma unroll
      for (int th = 0; th < 2; ++th) { bf16x8 kf[4][2];
#pragma unroll
        for (int t4 = 0; t4 < 4; ++t4)
#pragma unroll
          for (int s = 0; s < 2; ++s) kf[t4][s] = *(const bf16x8*)(lds + L_K + sw(16 * (4 * th + t4) + l15, 32 * s + 8 * g));
        __builtin_amdgcn_sched_barrier(0);
#pragma unroll
        for (int t4 = 0; t4 < 4; ++t4) { st[4 * th + t4] = (f32x4v){0.f, 0.f, 0.f, 0.f};
#pragma unroll
          for (int s = 0; s < 2; ++s) st[4 * th + t4] = mma(kf[t4][s], qf[s], st[4 * th + t4]); }
        __builtin_amdgcn_sched_barrier(0); }
#pragma unroll
      for (int t = 0; t < 8; ++t) st[t] *= *(const f32x4v*)(lds + L_DEC + (t * 512 + tid) * 16);
      f32x4v oi[4] = {};
#pragma unroll
      for (int sh = 0; sh < 2; ++sh) { s16x4 vlo[2][4], vhi[2][4];
#pragma unroll
        for (int s2 = 0; s2 < 2; ++s2)
#pragma unroll
          for (int u = 0; u < 4; ++u) { const int s = 2 * sh + s2; vlo[s2][u] = trd(lds + L_V + sw(32 * s + 4 * g + q, 16 * u + 4 * p)); vhi[s2][u] = trd(lds + L_V + sw(32 * s + 16 + 4 * g + q, 16 * u + 4 * p)); }
        __builtin_amdgcn_sched_barrier(0);
#pragma unroll
        for (int s2 = 0; s2 < 2; ++s2) { const int s = 2 * sh + s2; v4u w; w.x = cvt2(st[2 * s][0], st[2 * s][1]); w.y = cvt2(st[2 * s][2], st[2 * s][3]); w.z = cvt2(st[2 * s + 1][0], st[2 * s + 1][1]); w.w = cvt2(st[2 * s + 1][2], st[2 * s + 1][3]);
          const bf16x8 pf = __builtin_bit_cast(bf16x8, w);
#pragma unroll
          for (int u = 0; u < 4; ++u) oi[u] = mma(cat8(vlo[s2][u], vhi[s2][u]), pf, oi[u]); }
        __builtin_amdgcn_sched_barrier(0); }
      f32x4v cf[4] = {}, cb[4] = {};
#pragma unroll
      for (int s = 0; s < 2; ++s) { bf16x8 af[4], ab[4];
#pragma unroll
        for (int u = 0; u < 4; ++u) { af[u] = *(const bf16x8*)(lds + L_SF + sw(16 * u + l15, 32 * s + 8 * g)); ab[u] = *(const bf16x8*)(lds + L_SB + sw(16 * u + l15, 32 * s + 8 * g)); }
        __builtin_amdgcn_sched_barrier(0);
#pragma unroll
        for (int u = 0; u < 4; ++u) { cf[u] = mma(af[u], qf[s], cf[u]); cb[u] = mma(ab[u], qf[s], cb[u]); }
        __builtin_amdgcn_sched_barrier(0); }
      const float xf = exp2f(lgf * (float)(n + 1)), xb = exp2f(lgb * (float)(RCH - n));
      float s1 = 0.f;
#pragma unroll
      for (int u = 0; u < 4; ++u)
#pragma unroll
        for (int r = 0; r < 4; ++r) { oi[u][r] += xf * cf[u][r] + xb * cb[u][r]; s1 += oi[u][r]; }
      s1 += __shfl_xor(s1, 16); s1 += __shfl_xor(s1, 32);
      const float mu = s1 * (1.f / 64.f); float s2 = 0.f;
#pragma unroll
      for (int u = 0; u < 4; ++u)
#pragma unroll
        for (int r = 0; r < 4; ++r) { const float d = oi[u][r] - mu; s2 += d * d; }
      s2 += __shfl_xor(s2, 16); s2 += __shfl_xor(s2, 32);
      const float rs = __builtin_amdgcn_rsqf(s2 * (1.f / 64.f) + GN_EPS);
      bf16* op = MIX + (size_t)tok * DM + 4 * g;
#pragma unroll
      for (int u = 0; u < 4; ++u) { const v2u gw = gwv[u]; const float g0 = bflo(gw.x), g1 = bfhi(gw.x), g2 = bflo(gw.y), g3 = bfhi(gw.y);
#define RET_SILU(x) ((x) * __builtin_amdgcn_rcpf(1.0f + __builtin_amdgcn_exp2f(-1.4426950408889634f * (x))))
        const float y0 = RET_SILU(g0) * (oi[u][0] - mu) * rs, y1 = RET_SILU(g1) * (oi[u][1] - mu) * rs, y2 = RET_SILU(g2) * (oi[u][2] - mu) * rs, y3 = RET_SILU(g3) * (oi[u][3] - mu) * rs;
#undef RET_SILU
        v2u w; w.x = cvt2(y0, y1); w.y = cvt2(y2, y3); *(v2u*)(op + 16 * u) = w; }
        }
    sf[0] *= dec_f; sf[1] *= dec_f; kv_update(sf, lds, zf, v, u0, g, q, p);
    RET_BAR();
  }
#undef RET_ISSUE_L
#undef RET_ISSUE_H
}
__device__ __forceinline__ void run(const Args& a, unsigned char* lds, int bid, int G) {
  const int vcu = (G % 8 == 0) ? (bid % 8) * (G / 8) + bid / 8 : bid;
  for (int it = vcu; it < BH * 2; it += G) item(a, lds, it);
}
#undef RET_BAR
}

#define GAS __attribute__((address_space(1)))
typedef GAS unsigned gu32;
#define RLX_AGENT __ATOMIC_RELAXED, __HIP_MEMORY_SCOPE_AGENT
constexpr int CW_BAR = 4096;
constexpr size_t CTL_ZERO_BYTES = 65536;
#define XB_TMO      128
#define XB_XCNT(j)  (256  + 64 * (j))
#define XB_XSUB(j)  (1280 + 64 * (j))
#define XB_XGEN(j)  (2304 + 64 * (j))
#define XB_TOP      3328
#define XB_TOPGEN   3392
#define XCD_BAR_WORDS 3456
#define XB_SPIN_CAP (1u << 18)

__device__ __forceinline__ unsigned xb_ld(unsigned* p)              { return __hip_atomic_load(p, __ATOMIC_RELAXED, __HIP_MEMORY_SCOPE_AGENT); }
__device__ __forceinline__ unsigned xb_add(unsigned* p, unsigned v) { return __hip_atomic_fetch_add(p, v, __ATOMIC_RELAXED, __HIP_MEMORY_SCOPE_AGENT); }
__device__ __forceinline__ unsigned xb_xcc_id() { return (unsigned)__builtin_amdgcn_s_getreg((3 << 11) | 20) & 0xFu; }
#define XB_SPIN(cond, bar) do { unsigned _sp = 0; while (cond) { __builtin_amdgcn_s_sleep(1); \
    if ((++_sp & 255u) == 0u) { if (xb_ld(&(bar)[XB_TMO])) break; if (_sp > XB_SPIN_CAP) { atomicAdd(&(bar)[XB_TMO], 1u); break; } } } } while (0)

struct XcdBarrier {
    unsigned* bar; unsigned x;
    volatile LAS unsigned* st;
};

__device__ __forceinline__ XcdBarrier xcd_barrier_post(unsigned* bar, volatile LAS unsigned* st) {
    XcdBarrier b; b.bar = bar; b.x = xb_xcc_id(); b.st = st;
    if (threadIdx.x == 0) (void)xb_add(&bar[XB_XCNT(b.x)], 1u);
    return b;
}
__device__ __forceinline__ void xcd_barrier_complete(unsigned* bar, unsigned x, unsigned& nloc, unsigned& nx) {
    const unsigned G = gridDim.x * gridDim.y * gridDim.z;
    unsigned sum, cnt, mine, sp = 0u;
    for (;;) {
        sum = 0u; cnt = 0u; mine = 0u;
#pragma unroll
        for (unsigned j = 0; j < 16; ++j) { const unsigned c = xb_ld(&bar[XB_XCNT(j)]); sum += c; cnt += (c > 0u) ? 1u : 0u; mine = (j == x) ? c : mine; }
        if (sum == G) break;
        __builtin_amdgcn_s_sleep(1);
        if ((++sp & 255u) == 0u) { if (xb_ld(&bar[XB_TMO])) break; if (sp > XB_SPIN_CAP) { atomicAdd(&bar[XB_TMO], 1u); break; } }
    }
    nloc = mine > 0u ? mine : 1u; nx = cnt > 0u ? cnt : 1u;
}

__device__ __forceinline__ void xcd_barrier(const XcdBarrier& b) {
    asm volatile("s_waitcnt vmcnt(0)" ::: "memory");
    __syncthreads();
    if (threadIdx.x == 0) {
        unsigned* bar = b.bar;
        __builtin_amdgcn_s_waitcnt(0);
        unsigned nloc = b.st[0], nx = b.st[1];
        if (nloc == 0u) { xcd_barrier_complete(bar, b.x, nloc, nx); b.st[0] = nloc; b.st[1] = nx; }
        const unsigned old = xb_add(&bar[XB_XSUB(b.x)], 1u);
        const unsigned gen = old / nloc;
        if (old + 1u == (gen + 1u) * nloc) {
            __builtin_amdgcn_fence(__ATOMIC_RELEASE, "agent");
            asm volatile("s_waitcnt vmcnt(0)" ::: "memory");
            const unsigned og = xb_add(&bar[XB_TOP], 1u);
            const unsigned tg = og / nx;
            if (og + 1u == (tg + 1u) * nx) xb_add(&bar[XB_TOPGEN], 1u);
            else XB_SPIN(xb_ld(&bar[XB_TOPGEN]) == tg, bar);
            __builtin_amdgcn_fence(__ATOMIC_ACQUIRE, "agent");
            xb_add(&bar[XB_XGEN(b.x)], 1u);
            asm volatile("s_waitcnt vmcnt(0)" ::: "memory");
        } else {
            XB_SPIN(xb_ld(&bar[XB_XGEN(b.x)]) == gen, bar);
            __builtin_amdgcn_fence(__ATOMIC_ACQUIRE, "agent");
            asm volatile("s_waitcnt vmcnt(0)" ::: "memory");
        }
    }
    __syncthreads();
}

#ifndef EPI1
#define EPI1 EpiProj3
#define EPI1_ARG a.pos
#endif
#ifndef EPI1_ARG
#define EPI1_ARG (const float*)(ws + WS_ROT)
#endif
#ifndef EPI4
#define EPI4 EpiResid5
#endif
#ifndef EPI5
#define EPI5 EpiSwiGLU4
#endif
#ifndef EPI5_ARGS
#define EPI5_ARGS (const LAS int*)(ldsl + pg8::STAGE_BYTES), (const LAS float*)(ldsl + pg8::STAGE_BYTES + 1024)
#endif
#ifndef EPI6
#define EPI6 EpiOut5
#endif
#ifndef PG8_SP2
#define PG8_SP2 true
#endif
#ifndef PG8_ALIGN
#define PG8_ALIGN true
#endif
__global__ void __launch_bounds__(NTHR, 2) fwd_kernel(Args a) {
    extern __shared__ __attribute__((aligned(16))) unsigned char lds[];
    cg::grid_group grid = cg::this_grid();
    LAS unsigned char* ldsl = (LAS unsigned char*)lds;
    const int tid = threadIdx.x, lane = tid & 63, wave = __builtin_amdgcn_readfirstlane(tid >> 6);
    const int G = gridDim.x, bid = blockIdx.x;
    const int gw = bid * NWAVES + wave, NGW = G * NWAVES;
    unsigned char* ws = a.ws;
    volatile LAS unsigned* bst = (volatile LAS unsigned*)(ldsl + LDS_BYTES - 64);
    if (tid == 0) { bst[0] = 0u; bst[1] = 0u; }
    __syncthreads();
    const XcdBarrier xbar = xcd_barrier_post((unsigned*)ws + CW_BAR, bst);
    bf16* XN = (bf16*)(ws + WS_XN); bf16* PROJ = (bf16*)(ws + WS_PROJ); bf16* MIX = (bf16*)(ws + WS_MIX); bf16* ACT = (bf16*)(ws + WS_ACT); float* SSQ = (float*)(ws + WS_SSQ);

    p0_prologue(a, ldsl, gw, NGW, wave, lane);
    if (gridDim.y == 0x7fff) grid.sync();
    xcd_barrier(xbar);
    { pg8::Gemm g{XN, (const bf16*)(ws + WS_WIN), M, NINP, DM}; pg8::StaticOrder S; S.init(M, NINP, G, bid);
      pg8::EPI1 E{PROJ, NINP, EPI1_ARG};
      pg8::gemm_phase<pg8::EPI1, pg8::StaticOrder, PG8_ALIGN, PG8_SP2>(ldsl, g, S, E); }
    xcd_barrier(xbar);
    p2f::run(a, lds, bid, G);
    xcd_barrier(xbar);
    ret::run(a, lds, bid, G);
    p3_attn(a, lds, bid, G);
    xcd_barrier(xbar);
    { pg8::Gemm g{MIX, (const bf16*)(ws + WS_WO), M, DM, DM}; pg8::StaticOrder S; S.init(M, DM, G, bid);
      pg8::EPI4 E{a.x, XN, SSQ, DM};
      pg8::gemm_phase<pg8::EPI4, pg8::StaticOrder, PG8_ALIGN, PG8_SP2>(ldsl, g, S, E); }
    xcd_barrier(xbar);
    { float* RSTD = (float*)(ws + WS_RSTD); LAS int* plist = (LAS int*)(ldsl + pg8::STAGE_BYTES); LAS float* rtab = (LAS float*)(ldsl + pg8::STAGE_BYTES + 1024);
      if (tid == 0) plist[0] = 0;
      __syncthreads();
      { pg8::StaticOrder S5; S5.init(M, NGU, G, bid); pg8::Unit u5, up;
        for (int i = tid; S5.next(i, u5); i += NTHR) { const bool fresh = (i == 0) || (S5.next(i - 1, up) && up.pm != u5.pm);
            if (fresh) { const int n = __hip_atomic_fetch_add((int*)plist, 1, __ATOMIC_RELAXED, __HIP_MEMORY_SCOPE_WORKGROUP); if (n < 16) plist[1 + n] = u5.pm; } } }
      __syncthreads();
      const int np = plist[0] < 16 ? plist[0] : 16; if (tid == 0) plist[0] = np;
      for (int k = tid >> 8; k < np; k += 2) { const int r = plist[1 + k] * 256 + (tid & 255);
          const f32x4* sp = (const f32x4*)(SSQ + (size_t)r * 16); const f32x4 s0 = sp[0], s1 = sp[1], s2 = sp[2], s3 = sp[3];
          const float ss = ((s0[0] + s0[1]) + (s0[2] + s0[3])) + ((s1[0] + s1[1]) + (s1[2] + s1[3])) + ((s2[0] + s2[1]) + (s2[2] + s2[3])) + ((s3[0] + s3[1]) + (s3[2] + s3[3]));
          const float rv_ = 1.0f / sqrtf(ss * (1.f / DM) + EPS); RSTD[r] = rv_; rtab[k * 256 + (tid & 255)] = rv_; }
      asm volatile("s_waitcnt vmcnt(0)" ::: "memory");
      __syncthreads(); }
    { pg8::Gemm g{XN, (const bf16*)(ws + WS_WGU), M, NGU, DM}; pg8::StaticOrder S; S.init(M, NGU, G, bid);
      pg8::EPI5 E{ACT, DFF, EPI5_ARGS};
      pg8::gemm_phase<pg8::EPI5, pg8::StaticOrder, PG8_ALIGN, PG8_SP2>(ldsl, g, S, E); }
    xcd_barrier(xbar);
    { pg8::Gemm g{ACT, (const bf16*)(ws + WS_WDN), M, DM, DFF}; pg8::StaticOrder S; S.init(M, DM, G, bid);
      pg8::EPI6 E{XN, a.out, DM};
      pg8::gemm_phase<pg8::EPI6, pg8::StaticOrder, PG8_ALIGN, PG8_SP2>(ldsl, g, S, E); }
}

extern "C" void kernel_launch(void* const* d_in, const int* in_sizes, int n_in, void* d_out, int out_size, void* d_ws, size_t ws_size, hipStream_t stream) {
    static int grid = 0;
    if (grid == 0) {
        if (n_in != 17 || in_sizes[0] != M * DM || out_size != M * DM || ws_size < WS_END) { fprintf(stderr, "kernel_launch: unexpected shapes: n_in %d in0 %d out %d ws %zu (need >= %zu)\n", n_in, n_in > 0 ? in_sizes[0] : -1, out_size, ws_size, (size_t)WS_END); grid = -1; return; }
        int dev = 0, cus = 0, per_cu = 0;
        if (hipGetDevice(&dev) != hipSuccess || hipDeviceGetAttribute(&cus, hipDeviceAttributeMultiprocessorCount, dev) != hipSuccess) { fprintf(stderr, "kernel_launch: device query failed\n"); grid = -1; return; }
        if (hipFuncSetAttribute((const void*)fwd_kernel, hipFuncAttributeMaxDynamicSharedMemorySize, LDS_BYTES) != hipSuccess) { fprintf(stderr, "kernel_launch: hipFuncSetAttribute failed\n"); grid = -1; return; }
        if (hipOccupancyMaxActiveBlocksPerMultiprocessor(&per_cu, (const void*)fwd_kernel, NTHR, LDS_BYTES) != hipSuccess || per_cu < 1) { fprintf(stderr, "kernel_launch: occupancy query says %d blocks per CU\n", per_cu); (void)hipGetLastError(); per_cu = 1; }
        grid = cus * 1;
        fprintf(stderr, "kernel_launch: %d CUs, occupancy %d block(s)/CU, grid %d\n", cus, per_cu, grid);
    }
    if (grid < 0) return;
    if (hipMemsetAsync(d_ws, 0, CTL_ZERO_BYTES, stream) != hipSuccess) { fprintf(stderr, "kernel_launch: hipMemsetAsync failed\n"); return; }
    Args a{};
    a.x = (const float*)d_in[0]; a.pos = (const int*)d_in[1]; a.g1 = (const float*)d_in[2]; a.w_in = (const float*)d_in[3]; a.lf = (const float*)d_in[4]; a.lb = (const float*)d_in[5];
    a.qag = (const float*)d_in[6]; a.w_uq = (const float*)d_in[7]; a.kvag = (const float*)d_in[8]; a.w_ukv = (const float*)d_in[9]; a.qng = (const float*)d_in[10]; a.kng = (const float*)d_in[11];
    a.w_o = (const float*)d_in[12]; a.g2 = (const float*)d_in[13]; a.w_gate = (const float*)d_in[14]; a.w_up = (const float*)d_in[15]; a.w_down = (const float*)d_in[16];
    a.out = (float*)d_out; a.ws = (unsigned char*)d_ws;
    void* args[] = {&a};
    const hipError_t e = hipLaunchCooperativeKernel((const void*)fwd_kernel, dim3(grid), dim3(NTHR), args, LDS_BYTES, stream);
    if (e != hipSuccess) fprintf(stderr, "kernel_launch: cooperative launch failed: %s (grid %d)\n", hipGetErrorString(e), grid);
}
```
